# Optimizing an MI355X kernel written in HIP

```python
import math
import jax, jax.numpy as jnp
from jax import lax
import numpy as np

D_MODEL = 2048
BATCH = 4
SEQ = 2048
DEPTH = 1

N_MEM = 256
EPS = 1e-6
GLA_HEADS = 4
GLA_DK_TOTAL = D_MODEL // 2
GLA_DV_TOTAL = D_MODEL
GLA_DK = GLA_DK_TOTAL // GLA_HEADS
GLA_DV = GLA_DV_TOTAL // GLA_HEADS
GLA_RANK = 16
GLA_TAU = 16.0
GLA_CHUNK = 64
SB_HEAD_DIM = 128
SB_HEADS = D_MODEL // SB_HEAD_DIM
SB_WIDTH = SB_HEADS * SB_HEAD_DIM
SB_BLOCK = 128
MEM_HEADS = 4
MEM_WIDTH = D_MODEL
MEM_HEAD_DIM = MEM_WIDTH // MEM_HEADS
N_BRANCHES = 3

IN_SPLIT_SIZES = (
    GLA_DK_TOTAL,
    GLA_DK_TOTAL,
    GLA_DV_TOTAL,
    GLA_DV_TOTAL,
    GLA_RANK,
    SB_WIDTH,
    SB_WIDTH,
    SB_WIDTH,
    SB_WIDTH,
    MEM_WIDTH,
    N_BRANCHES * D_MODEL,
)
IN_TOTAL = sum(IN_SPLIT_SIZES)

kernel_name = "hybrid_gla_stickbreak_memory_layer"


def rmsnorm(x, g):
    xf = x.astype(jnp.float32)
    y = xf * lax.rsqrt(jnp.mean(xf * xf, axis=-1, keepdims=True) + EPS)
    return (y * g.astype(jnp.float32)).astype(x.dtype)


def split_heads(t, n_heads):
    b, s, w = t.shape
    return t.reshape(b, s, n_heads, w // n_heads).transpose(0, 2, 1, 3)


def merge_heads(t):
    b, h, s, d = t.shape
    return t.transpose(0, 2, 1, 3).reshape(b, s, h * d)


def gla_chunked(q, k, v, log_a):
    B, H, T, dk = q.shape
    dv = v.shape[-1]
    C = GLA_CHUNK
    N = T // C
    f32 = jnp.float32

    def to_chunks(t):
        return t.astype(f32).reshape(B, H, N, C, t.shape[-1]).transpose(2, 0, 1, 3, 4)

    qc, kc, vc, ac = (to_chunks(t) for t in (q, k, v, log_a))
    causal = jnp.tril(jnp.ones((C, C), dtype=bool))[:, :, None]

    def step(S, inp):
        qi, ki, vi, ai = inp
        b = jnp.cumsum(ai, axis=-2)
        o_inter = jnp.einsum('bhck,bhkv->bhcv', qi * jnp.exp(b), S)
        diff = b[:, :, :, None, :] - b[:, :, None, :, :]
        decay = jnp.exp(jnp.where(causal, diff, -jnp.inf))
        attn = jnp.sum(qi[:, :, :, None, :] * ki[:, :, None, :, :] * decay, axis=-1)
        o_intra = jnp.einsum('bhij,bhjv->bhiv', attn, vi)
        b_last = b[:, :, -1:, :]
        S_new = (jnp.exp(b_last[:, :, 0, :])[..., None] * S
                 + jnp.einsum('bhck,bhcv->bhkv', ki * jnp.exp(b_last - b), vi))
        return S_new, o_inter + o_intra

    S0 = jnp.zeros((B, H, dk, dv), f32)
    _, o = lax.scan(step, S0, (qc, kc, vc, ac))
    return o.transpose(1, 2, 0, 3, 4).reshape(B, H, T, dv).astype(v.dtype)


def stick_breaking(q, k, v):
    B, H, T, d = q.shape
    scale = 1.0 / math.sqrt(d)
    outs = []
    for blk in range(T // SB_BLOCK):
        q0 = blk * SB_BLOCK
        kend = q0 + SB_BLOCK
        qb = q[:, :, q0:kend]
        kb = k[:, :, :kend]
        vb = v[:, :, :kend]
        z = jnp.einsum('bhtd,bhsd->bhts', qb, kb).astype(jnp.float32) * scale
        t_idx = q0 + jnp.arange(SB_BLOCK)[:, None]
        s_idx = jnp.arange(kend)[None, :]
        strict = s_idx < t_idx
        log_1m_beta = jnp.where(strict, jax.nn.log_sigmoid(-z), 0.0)
        after = lax.cumsum(log_1m_beta, axis=3, reverse=True) - log_1m_beta
        log_w = jax.nn.log_sigmoid(z) + after
        w = jnp.where(strict, jnp.exp(log_w), 0.0)
        outs.append(jnp.einsum('bhts,bhsd->bhtd', w.astype(v.dtype), vb))
    return jnp.concatenate(outs, axis=2)


def memory_attention(q, k, v):
    d = q.shape[-1]
    s = jnp.einsum('bhtd,bhmd->bhtm', q, k).astype(jnp.float32) / math.sqrt(d)
    p = jax.nn.softmax(s, axis=-1).astype(v.dtype)
    return jnp.einsum('bhtm,bhmd->bhtd', p, v)


def setup_inputs(seed: int = 0) -> dict:
    key = jax.random.key(seed)
    ks = jax.random.split(key, 16)
    f32 = jnp.float32
    D = D_MODEL
    nrm = lambda k, shape, fan_in: jax.random.normal(k, shape, f32) * (fan_in ** -0.5)
    gain = lambda k, n: 1.0 + 0.02 * jax.random.normal(k, (n,), f32)
    return {
        "x": jax.random.normal(ks[0], (BATCH, SEQ, D), f32),
        "mem": jax.random.normal(ks[1], (BATCH, N_MEM, D), f32),
        "norm_pre_g": gain(ks[2], D),
        "norm_post_g": gain(ks[3], D),
        "norm_mem_g": gain(ks[4], D),
        "w_in": nrm(ks[5], (D, IN_TOTAL), D),
        "gla_a_w2": nrm(ks[6], (GLA_RANK, GLA_DK_TOTAL), GLA_RANK),
        "gla_a_b": 0.1 * jax.random.normal(ks[7], (GLA_DK_TOTAL,), f32),
        "gla_head_norm_g": gain(ks[8], GLA_DV),
        "w_mem_kv": nrm(ks[9], (D, 2 * MEM_WIDTH), D),
        "w_proj_gla": nrm(ks[10], (GLA_DV_TOTAL, D), GLA_DV_TOTAL),
        "w_proj_sb": nrm(ks[11], (SB_WIDTH, D), SB_WIDTH),
        "w_proj_mem": nrm(ks[12], (MEM_WIDTH, D), MEM_WIDTH),
        "w_out": nrm(ks[13], (D, D), D),
    }


def reference(x, mem, norm_pre_g, norm_post_g, norm_mem_g, w_in, gla_a_w2, gla_a_b,
              gla_head_norm_g, w_mem_kv, w_proj_gla, w_proj_sb, w_proj_mem, w_out):
    B, T, D = x.shape
    mem_h = rmsnorm(mem, norm_mem_g)
    mk, mv = jnp.split(mem_h @ w_mem_kv, 2, axis=-1)
    mk, mv = split_heads(mk, MEM_HEADS), split_heads(mv, MEM_HEADS)

    for _ in range(DEPTH):
        h = rmsnorm(x, norm_pre_g)
        proj = h @ w_in
        idx = np.cumsum(IN_SPLIT_SIZES)[:-1].tolist()
        (gq, gk, gv, gg, ga, sq, sk, sv, sg, mq, gates) = jnp.split(proj, idx, axis=-1)

        log_a = jax.nn.log_sigmoid(
            (ga @ gla_a_w2 + gla_a_b).astype(jnp.float32)) / GLA_TAU
        o_a = gla_chunked(split_heads(gq * (GLA_DK ** -0.5), GLA_HEADS),
                          split_heads(gk, GLA_HEADS),
                          split_heads(gv, GLA_HEADS),
                          split_heads(log_a, GLA_HEADS))
        o_a = merge_heads(rmsnorm(o_a, gla_head_norm_g)) * jax.nn.silu(gg)

        o_b = stick_breaking(split_heads(sq, SB_HEADS),
                             split_heads(sk, SB_HEADS),
                             split_heads(sv, SB_HEADS))
        o_b = merge_heads(o_b) * jax.nn.silu(sg)

        o_m = merge_heads(memory_attention(split_heads(mq, MEM_HEADS), mk, mv))

        g_a, g_b, g_m = jnp.split(jax.nn.sigmoid(gates), N_BRANCHES, axis=-1)
        merged = (g_a * (o_a @ w_proj_gla)
                  + g_b * (o_b @ w_proj_sb)
                  + g_m * (o_m @ w_proj_mem))
        y = merged @ w_out
        x = x + rmsnorm(y, norm_post_g)
    return x
```

```cpp
#include <hip/hip_runtime.h>
#include <hip/hip_cooperative_groups.h>
#include <cstdio>
namespace cg = cooperative_groups;

#ifndef PROBE_DUP
#define PROBE_DUP -1
#endif
#ifndef PROBE_PART
#define PROBE_PART 7
#endif
#ifndef MK_MULTI
#define MK_MULTI 0
#endif

typedef unsigned short bf16_t;
typedef short bf16x8 __attribute__((ext_vector_type(8)));
typedef float f32x2 __attribute__((ext_vector_type(2)));
typedef float f32x4 __attribute__((ext_vector_type(4)));
typedef float f32x16 __attribute__((ext_vector_type(16)));
typedef unsigned u32x2 __attribute__((ext_vector_type(2)));
typedef unsigned u32x4 __attribute__((ext_vector_type(4)));
typedef __bf16 bf16x2_t __attribute__((ext_vector_type(2)));
#define DEV __device__ __forceinline__

constexpr int NTOK = 8192, DM = 2048, NPROJ = 22528;
constexpr size_t MiB = 1048576;
constexpr size_t OFF_WT_IN = 0, OFF_WT_MKV = 88 * MiB, OFF_WT_PG = 104 * MiB, OFF_WT_PS = 112 * MiB, OFF_WT_PM = 120 * MiB, OFF_WT_OUT = 128 * MiB,
                 OFF_H = 136 * MiB, OFF_MEMH = 168 * MiB, OFF_B = 172 * MiB, OFF_EB = 204 * MiB, OFF_MISC = 206 * MiB,
                 OFF_QP = 208 * MiB, OFF_KDP = 224 * MiB, OFF_KET = 240 * MiB, OFF_GVT = 256 * MiB, OFF_SGG = 288 * MiB, OFF_SQ = 320 * MiB,
                 OFF_SK = 352 * MiB, OFF_SVT = 384 * MiB, OFF_SSG = 416 * MiB, OFF_MQ = 448 * MiB, OFF_GATES = 480 * MiB, OFF_MK = 576 * MiB,
                 OFF_MVT = 580 * MiB;
constexpr size_t OFF_OP0 = OFF_WT_IN, OFF_OP1 = 584 * MiB, OFF_OB = OFF_H, OFF_OM = OFF_B, OFF_OA = 32 * MiB, OFF_MERGED = 584 * MiB, OFF_MBF = 616 * MiB, OFF_Y = 648 * MiB;
constexpr size_t OFF_PART = OFF_MISC + 4096;

struct Params {
  const float *x, *mem, *g_pre, *g_post, *g_mem, *w_in, *a_w2, *a_b, *g_head, *w_mkv, *w_pg, *w_ps, *w_pm, *w_out;
  float* out; char* ws;
};

extern __shared__ __attribute__((aligned(16))) char smem[];

DEV unsigned pk_bf16(float a, float b) { f32x2 v = {a, b}; bf16x2_t r = __builtin_convertvector(v, bf16x2_t); return __builtin_bit_cast(unsigned, r); }
DEV float bf_lo(unsigned u) { return __uint_as_float(u << 16); }
DEV float bf_hi(unsigned u) { return __uint_as_float(u & 0xffff0000u); }
DEV float wave_sum(float v) { for (int o = 32; o; o >>= 1) v += __shfl_xor(v, o); return v; }
DEV bf16x8 ld16(const bf16_t* p) { return *(const bf16x8*)p; }
DEV f32x16 mfma32(bf16x8 a, bf16x8 b, f32x16 c) { return __builtin_amdgcn_mfma_f32_32x32x16_bf16(a, b, c, 0, 0, 0); }
template <int S> DEV bf16x8 cvt8(const f32x16& v) {
  u32x4 p = {pk_bf16(v[8 * S], v[8 * S + 1]), pk_bf16(v[8 * S + 2], v[8 * S + 3]), pk_bf16(v[8 * S + 4], v[8 * S + 5]), pk_bf16(v[8 * S + 6], v[8 * S + 7])};
  return __builtin_bit_cast(bf16x8, p);
}
DEV u32x2 pk4(f32x4 v) { u32x2 r = {pk_bf16(v[0], v[1]), pk_bf16(v[2], v[3])}; return r; }
DEV f32x4 unpk4(u32x2 u) { f32x4 r = {bf_lo(u[0]), bf_hi(u[0]), bf_lo(u[1]), bf_hi(u[1])}; return r; }
DEV int sig4(int x) { return ((x & 1) << 1) | (x >> 1); }
DEV int sig16(int p) { return 8 * ((p >> 2) & 1) + 4 * (p >> 3) + (p & 3); }
DEV int otid() { int t = threadIdx.x; asm volatile("" : "+v"(t)); return t; }
DEV float fsigmoid(float x) { return 1.f / (1.f + __expf(-x)); }
DEV float logsigmoid(float x) { return fminf(x, 0.f) - __logf(1.f + __expf(-fabsf(x))); }

constexpr int BM = 256, BK = 64, HALF = 128, HT = HALF * BK;
DEV int lds_byte(int r, int c) { int st = (r >> 4) * 2 + (c >> 5), rr = r & 15, cc = c & 31, ob = rr * 64 + cc * 2; return st * 1024 + (ob ^ (((ob >> 9) & 1) << 5)); }
DEV void stage_rc(int b, int& R, int& C) { int st = b / 1024, sb = b % 1024, swz = sb ^ (((sb >> 9) & 1) << 5); R = (st >> 1) * 16 + swz / 64; C = (st & 1) * 32 + (swz % 64) / 2; }

template <bool SWAP, class Epi>
DEV void gemm_tile(const bf16_t* __restrict__ A, const bf16_t* __restrict__ Bt, const int K, const int brow, const int bcol, const Epi& epi) {
  bf16_t* shm = (bf16_t*)smem;
#define SA(b, h) (shm + ((b) * 2 + (h)) * HT)
#define SB(b, h) (shm + (4 + (b) * 2 + (h)) * HT)
#define STAGE(P, BASE, br, kt) do { const char* _gb = (const char*)(BASE) + (((long)(br) * K + (long)(kt) * BK) << 1); \
    __builtin_amdgcn_global_load_lds((const unsigned*)(_gb + so0), (unsigned*)((char*)(P) + tb), 16, 0, 0); \
    __builtin_amdgcn_global_load_lds((const unsigned*)(_gb + so1), (unsigned*)((char*)(P) + tb + 8192), 16, 0, 0); } while (0)
#define LDA(dst, b, h) for (int m = 0; m < 4; ++m) for (int k = 0; k < 2; ++k) \
    dst[m][k] = *reinterpret_cast<const bf16x8*>((char*)SA(b, h) + a_rd + m * 2048 + k * 1024)
#define LDB(dst, b, h) for (int n = 0; n < 2; ++n) for (int k = 0; k < 2; ++k) \
    dst[n][k] = *reinterpret_cast<const bf16x8*>((char*)SB(b, h) + b_rd + n * 2048 + k * 1024)
#define MMA(ai, bj, At_, Bt_) do { __builtin_amdgcn_s_setprio(1); \
    for (int m = 0; m < 4; ++m) for (int n = 0; n < 2; ++n) for (int k = 0; k < 2; ++k) \
      acc[ai][bj][m][n] = SWAP ? __builtin_amdgcn_mfma_f32_16x16x32_bf16(Bt_[n][k], At_[m][k], acc[ai][bj][m][n], 0, 0, 0) \
                               : __builtin_amdgcn_mfma_f32_16x16x32_bf16(At_[m][k], Bt_[n][k], acc[ai][bj][m][n], 0, 0, 0); \
    __builtin_amdgcn_s_setprio(0); } while (0)
#define WAIT_V(n) asm volatile("s_waitcnt vmcnt(" #n ")" ::: "memory")
#define WAIT_L(n) asm volatile("s_waitcnt lgkmcnt(" #n ")" ::: "memory")
#define BAR __builtin_amdgcn_s_barrier()
#define SCHED __builtin_amdgcn_sched_barrier(0)
  const int tidx = otid();
  const int wid = tidx >> 6, lane = tidx & 63, wr = wid >> 2, wc = wid & 3, fr = lane & 15, fq = lane >> 4;
  f32x4 acc[2][2][4][2] = {};
  bf16x8 At[4][2], B0[2][2], B1[2][2];
  const int nt = K / BK;
  const int tb = tidx * 16;
  unsigned so0, so1;
  { int r_, c_; stage_rc(tb, r_, c_); so0 = (unsigned)(r_ * K + c_) * 2u; stage_rc(tb + 8192, r_, c_); so1 = (unsigned)(r_ * K + c_) * 2u; }
  const int tb16 = (fr * 64 + fq * 16) ^ ((fr >> 3) << 5);
  const int a_rd = wr * 8192 + tb16, b_rd = wc * 4096 + tb16;
  WAIT_V(0);
  __syncthreads();
  STAGE(SB(0, 0), Bt, bcol, 0); STAGE(SA(0, 0), A, brow, 0);
  STAGE(SB(0, 1), Bt, bcol + HALF, 0); STAGE(SA(0, 1), A, brow + HALF, 0);
  if (wr == 1) BAR;
  WAIT_V(4); BAR;
  STAGE(SB(1, 0), Bt, bcol, 1); STAGE(SA(1, 0), A, brow, 1); STAGE(SB(1, 1), Bt, bcol + HALF, 1);
  WAIT_V(6); BAR;
#pragma unroll 1
  for (int t = 0; t < nt - 2; t += 2) {
    LDB(B0, 0, 0); SCHED; LDA(At, 0, 0); STAGE(SA(1, 1), A, brow + HALF, t + 1);
    WAIT_L(8); BAR; WAIT_L(0); MMA(0, 0, At, B0); BAR; SCHED;
    LDB(B1, 0, 1); STAGE(SB(0, 0), Bt, bcol, t + 2);
    BAR; WAIT_L(0); MMA(0, 1, At, B1); BAR;
    LDA(At, 0, 1); STAGE(SA(0, 0), A, brow, t + 2);
    BAR; WAIT_L(0); MMA(1, 0, At, B0); BAR; SCHED;
    STAGE(SB(0, 1), Bt, bcol + HALF, t + 2);
    WAIT_V(6); BAR; MMA(1, 1, At, B1); BAR;
    LDB(B0, 1, 0); SCHED; LDA(At, 1, 0); STAGE(SA(0, 1), A, brow + HALF, t + 2);
    WAIT_L(8); BAR; WAIT_L(0); MMA(0, 0, At, B0); BAR; SCHED;
    LDB(B1, 1, 1); STAGE(SB(1, 0), Bt, bcol, t + 3);
    BAR; WAIT_L(0); MMA(0, 1, At, B1); BAR;
    LDA(At, 1, 1); STAGE(SA(1, 0), A, brow, t + 3);
    BAR; WAIT_L(0); MMA(1, 0, At, B0); BAR; SCHED;
    STAGE(SB(1, 1), Bt, bcol + HALF, t + 3);
    WAIT_V(6); BAR; MMA(1, 1, At, B1); BAR;
  }
  { LDB(B0, 0, 0); LDA(At, 0, 0); STAGE(SA(1, 1), A, brow + HALF, nt - 1);
    BAR; WAIT_L(0); MMA(0, 0, At, B0); BAR;
    LDB(B1, 0, 1); BAR; WAIT_L(0); MMA(0, 1, At, B1); BAR;
    LDA(At, 0, 1); WAIT_V(4); BAR; WAIT_L(0); MMA(1, 0, At, B0); MMA(1, 1, At, B1); BAR; }
  { LDB(B0, 1, 0); LDA(At, 1, 0); WAIT_V(2); BAR; WAIT_L(0); MMA(0, 0, At, B0); BAR;
    LDB(B1, 1, 1); WAIT_V(0); BAR; WAIT_L(0); MMA(0, 1, At, B1); BAR;
    LDA(At, 1, 1); BAR; WAIT_L(0); MMA(1, 0, At, B0); MMA(1, 1, At, B1); BAR; }
  if (wr == 0) BAR;
  {
    int tx = tidx, br2 = brow, bc2 = bcol;
    asm volatile("" : "+v"(tx), "+s"(br2), "+s"(bc2));
    const int wid2 = tx >> 6, lane2 = tx & 63;
    epi(acc, br2, bc2, wid2 >> 2, wid2 & 3, lane2 & 15, lane2 >> 4);
  }
#undef SA
#undef SB
}

DEV void tile_rows_out(bf16_t* __restrict__ out0, const size_t ld, const int tid) {
#pragma unroll
  for (int i = 0; i < 16; ++i) {
    const int id = i * 512 + tid, r = id >> 5, pos = id & 31, c = pos ^ (r & 31);
    *(u32x4*)(out0 + (size_t)r * ld + 8 * c) = *(const u32x4*)(smem + r * 512 + pos * 16);
  }
}
DEV void tile_rows_in(const bf16_t* __restrict__ src0, const size_t ld, const int tid) {
#pragma unroll 1
  for (int io = 0; io < 4; ++io) {
    u32x4 v[4];
#pragma unroll
    for (int ii = 0; ii < 4; ++ii) {
      const int id = (io * 4 + ii) * 512 + tid, r = id >> 5, pos = id & 31, c = pos ^ (r & 31);
      v[ii] = *(const u32x4*)(src0 + (size_t)r * ld + 8 * c);
    }
#pragma unroll
    for (int ii = 0; ii < 4; ++ii) {
      const int id = (io * 4 + ii) * 512 + tid, r = id >> 5, pos = id & 31;
      *(u32x4*)(smem + r * 512 + pos * 16) = v[ii];
    }
  }
}
DEV u32x2 tile_get4(const int r, const int col4) { return *(const u32x2*)(smem + r * 512 + ((((col4 >> 3)) ^ (r & 31)) * 16) + ((col4 & 4) << 1)); }
DEV void tile_put4(const int r, const int col4, const u32x2 v) {
  *(u32x2*)(smem + r * 512 + ((((col4 >> 3)) ^ (r & 31)) * 16) + ((col4 & 4) << 1)) = v;
}
struct EpiP1 {
  int mode;
  bf16_t* out; int ld; int segstart; float scale; const float* bmat; bf16_t* keT;
  DEV void operator()(f32x4 (&acc)[2][2][4][2], int brow, int bcol, int wr, int wc, int fr, int fq) const {
#pragma unroll
    for (int ai = 0; ai < 2; ++ai)
#pragma unroll
      for (int m = 0; m < 4; ++m) {
        const int rl = ai * 128 + wr * 64 + m * 16 + fr, tok = brow + rl;
#pragma unroll
        for (int bj = 0; bj < 2; ++bj)
#pragma unroll
          for (int n = 0; n < 2; ++n) {
            const int cl = bj * 128 + wc * 32 + n * 16 + fq * 4, lc = bcol - segstart + cl;
            f32x4 v = acc[ai][bj][m][n];
            if (mode == 0) {
              tile_put4(rl, cl, pk4(v * scale));
            } else if (mode == 1) {
              for (int j = 0; j < 4; ++j) v[j] = v[j] * fsigmoid(v[j]);
              tile_put4(rl, cl, pk4(v));
            } else if (mode == 2) {
              for (int j = 0; j < 4; ++j) v[j] = fsigmoid(v[j]);
              tile_put4(rl, cl, pk4(v));
            } else {
              const f32x4 b4 = *(const f32x4*)(bmat + (size_t)tok * 1024 + lc);
              const int pcl = (cl & ~15) + 4 * sig4((cl >> 2) & 3);
              if (mode == 3) {
                for (int j = 0; j < 4; ++j) v[j] = v[j] * scale * __expf(b4[j]);
                tile_put4(rl, pcl, pk4(v));
              } else {
                const f32x4 bl = *(const f32x4*)(bmat + (size_t)(tok | 63) * 1024 + lc);
                f32x4 kd, ke;
                for (int j = 0; j < 4; ++j) { kd[j] = v[j] * __expf(-b4[j]); ke[j] = v[j] * __expf(bl[j] - b4[j]); }
                tile_put4(rl, pcl, pk4(kd));
                (void)ke;
              }
            }
          }
      }
    __syncthreads();
    tile_rows_out(out + (size_t)brow * ld + (bcol - segstart), (size_t)ld, (wr * 4 + wc) * 64 + fq * 16 + fr);
    if (mode == 4) {
      __syncthreads();
#pragma unroll
      for (int ai = 0; ai < 2; ++ai)
#pragma unroll
        for (int m = 0; m < 4; ++m) {
          const int rl = ai * 128 + wr * 64 + m * 16 + fr, tok = brow + rl;
          const int tposl = (rl & ~15) + sig16(rl & 15);
#pragma unroll
          for (int bj = 0; bj < 2; ++bj)
#pragma unroll
            for (int n = 0; n < 2; ++n) {
              const int cl = bj * 128 + wc * 32 + n * 16 + fq * 4, lc = bcol - segstart + cl;
              const f32x4 v = acc[ai][bj][m][n];
              const f32x4 b4 = *(const f32x4*)(bmat + (size_t)tok * 1024 + lc);
              const f32x4 bl = *(const f32x4*)(bmat + (size_t)(tok | 63) * 1024 + lc);
              const u32x2 kk = pk4((f32x4){v[0] * __expf(bl[0] - b4[0]), v[1] * __expf(bl[1] - b4[1]), v[2] * __expf(bl[2] - b4[2]), v[3] * __expf(bl[3] - b4[3])});
#pragma unroll
              for (int j = 0; j < 4; ++j) {
                const int row = cl + j;
                const unsigned short val = (unsigned short)((j & 1) ? (kk[j >> 1] >> 16) : (kk[j >> 1] & 0xffff));
                *(unsigned short*)(smem + row * 512 + (((tposl >> 3) ^ (row & 31)) * 16) + (tposl & 7) * 2) = val;
              }
            }
        }
      __syncthreads();
      const int bt = brow >> 11, tl0 = brow & 2047, hd = (bcol - segstart) >> 8;
      tile_rows_out(keT + ((size_t)((bt * 4 + hd) * 256)) * 2048 + tl0, 2048, (wr * 4 + wc) * 64 + fq * 16 + fr);
    }
  }
};
struct EpiVT {
  bf16_t* out; int nch; int tshift; int segstart;
  DEV void operator()(f32x4 (&acc)[2][2][4][2], int brow, int bcol, int wr, int wc, int fr, int fq) const {
    const int T = 1 << tshift;
#pragma unroll
    for (int ai = 0; ai < 2; ++ai)
#pragma unroll
      for (int m = 0; m < 4; ++m) {
        const int tposl = ai * 128 + wr * 64 + m * 16 + 4 * sig4(fq);
#pragma unroll
        for (int bj = 0; bj < 2; ++bj)
#pragma unroll
          for (int n = 0; n < 2; ++n) tile_put4(bj * 128 + wc * 32 + n * 16 + fr, tposl, pk4(acc[ai][bj][m][n]));
      }
    __syncthreads();
    const int bt = brow >> tshift, tl0 = brow & (T - 1);
    tile_rows_out(out + ((size_t)(bt * nch + (bcol - segstart)) << tshift) + tl0, (size_t)T, (wr * 4 + wc) * 64 + fq * 16 + fr);
  }
};
struct EpiMerge {
  int step; int gidx; const bf16_t* gates; float* mg; bf16_t* mbf;
  DEV void operator()(f32x4 (&acc)[2][2][4][2], int brow, int bcol, int wr, int wc, int fr, int fq) const {
    const int tid = (wr * 4 + wc) * 64 + fq * 16 + fr;
    u32x2* sp = (u32x2*)mg + ((size_t)((brow >> 8) * 8 + (bcol >> 8)) * 32) * 512 + tid;
    tile_rows_in(gates + (size_t)brow * 6144 + gidx * 2048 + bcol, 6144, tid);
    __syncthreads();
#pragma unroll
    for (int ai = 0; ai < 2; ++ai)
#pragma unroll
      for (int m = 0; m < 4; ++m) {
        const int rl = ai * 128 + wr * 64 + m * 16 + fr, tok = brow + rl;
#pragma unroll
        for (int bj = 0; bj < 2; ++bj)
#pragma unroll
          for (int n = 0; n < 2; ++n) {
            const int cl = bj * 128 + wc * 32 + n * 16 + fq * 4, col = bcol + cl;
            const int f = ((ai * 4 + m) * 2 + bj) * 2 + n;
            const f32x4 g = unpk4(tile_get4(rl, cl));
            f32x4 v = acc[ai][bj][m][n] * g;
            if (step == 0) sp[(size_t)f * 512] = pk4(v);
            else if (step == 1) sp[(size_t)f * 512] = pk4(unpk4(sp[(size_t)f * 512]) + v);
            else tile_put4(rl, cl, pk4(unpk4(sp[(size_t)f * 512]) + v));
          }
      }
    if (step == 2) {
      __syncthreads();
      tile_rows_out(mbf + (size_t)brow * 2048 + bcol, 2048, tid);
    }
  }
};
struct EpiOut {
  bf16_t* y; float* part;
  DEV void operator()(f32x4 (&acc)[2][2][4][2], int brow, int bcol, int wr, int wc, int fr, int fq) const {
    const int tid = (wr * 4 + wc) * 64 + fq * 16 + fr;
#pragma unroll
    for (int ai = 0; ai < 2; ++ai)
#pragma unroll
      for (int m = 0; m < 4; ++m) {
        const int rl = ai * 128 + wr * 64 + m * 16 + fr, tok = brow + rl;
        float ss = 0.f;
#pragma unroll
        for (int bj = 0; bj < 2; ++bj)
#pragma unroll
          for (int n = 0; n < 2; ++n) {
            const int cl = bj * 128 + wc * 32 + n * 16 + fq * 4;
            const f32x4 v = acc[ai][bj][m][n];
            tile_put4(rl, cl, pk4(v));
            ss += v[0] * v[0] + v[1] * v[1] + v[2] * v[2] + v[3] * v[3];
          }
        ss += __shfl_xor(ss, 16); ss += __shfl_xor(ss, 32);
        if (fq == 0) part[(size_t)((bcol >> 8) * 4 + wc) * NTOK + tok] = ss;
      }
    __syncthreads();
    tile_rows_out(y + (size_t)brow * 2048 + bcol, 2048, tid);
  }
};

DEV void norm_rows64(const float* __restrict__ src, const float* __restrict__ g, bf16_t* __restrict__ dst, int r0) {
  const int tidx = otid();
  const int wave = tidx >> 6, lane = tidx & 63;
  for (int rr = 0; rr < 8; rr += 2) {
    const int row = r0 + wave * 8 + rr;
    const f32x4* xr = (const f32x4*)(src + (size_t)row * DM);
    f32x4 v[2][8]; float ss0 = 0.f, ss1 = 0.f;
#pragma unroll
    for (int i = 0; i < 8; ++i) { v[0][i] = xr[lane + 64 * i]; v[1][i] = xr[512 + lane + 64 * i]; }
#pragma unroll
    for (int i = 0; i < 8; ++i) {
      ss0 += v[0][i][0] * v[0][i][0] + v[0][i][1] * v[0][i][1] + v[0][i][2] * v[0][i][2] + v[0][i][3] * v[0][i][3];
      ss1 += v[1][i][0] * v[1][i][0] + v[1][i][1] * v[1][i][1] + v[1][i][2] * v[1][i][2] + v[1][i][3] * v[1][i][3];
    }
    ss0 = wave_sum(ss0); ss1 = wave_sum(ss1);
    const float rs[2] = {rsqrtf(ss0 * (1.f / DM) + 1e-6f), rsqrtf(ss1 * (1.f / DM) + 1e-6f)};
#pragma unroll
    for (int i = 0; i < 8; ++i) {
      const f32x4 g4 = ((const f32x4*)g)[lane + 64 * i];
#pragma unroll
      for (int r = 0; r < 2; ++r) *(u32x2*)(dst + (size_t)(row + r) * DM + 4 * (lane + 64 * i)) = pk4(v[r][i] * rs[r] * g4);
    }
  }
}

DEV void p0_chunk(const Params& p, int item) {
  const int tid = otid(), wave = tid >> 6, lane = tid & 63;
  const int r0 = item * 64;
  bf16_t* h = (bf16_t*)(p.ws + OFF_H);
  norm_rows64(p.x, p.g_pre, h, r0);
  __syncthreads();
  float* gaL = (float*)smem;
  {
    const int row = lane & 15, kg = lane >> 4, tg = wave & 3, kh = wave >> 2;
    const bf16_t* ap = h + (size_t)(r0 + tg * 16 + row) * DM + 8 * kg + 1024 * kh;
    const float* wp = p.w_in + (size_t)(8 * kg + 1024 * kh) * 22544 + 6144 + row;
    f32x4 acc = {0.f, 0.f, 0.f, 0.f};
#pragma unroll 8
    for (int s = 0; s < 32; ++s) {
      const bf16x8 a = ld16(ap + 32 * s);
      float w[8];
#pragma unroll
      for (int e = 0; e < 8; ++e) w[e] = wp[(size_t)(32 * s + e) * 22544];
      u32x4 bw = {pk_bf16(w[0], w[1]), pk_bf16(w[2], w[3]), pk_bf16(w[4], w[5]), pk_bf16(w[6], w[7])};
      acc = __builtin_amdgcn_mfma_f32_16x16x32_bf16(a, __builtin_bit_cast(bf16x8, bw), acc, 0, 0, 0);
    }
#pragma unroll
    for (int j = 0; j < 4; ++j) gaL[kh * 1024 + (tg * 16 + kg * 4 + j) * 16 + row] = acc[j];
  }
  __syncthreads();
  float* bmat = (float*)(p.ws + OFF_B);
  float* eb = (float*)(p.ws + OFF_EB);
  float w2c[2][16], bias[2], run[2] = {0.f, 0.f};
#pragma unroll
  for (int k = 0; k < 2; ++k) {
    const int c = tid + 512 * k;
    bias[k] = p.a_b[c];
#pragma unroll
    for (int r = 0; r < 16; ++r) w2c[k][r] = p.a_w2[r * 1024 + c];
  }
  for (int tok = 0; tok < 64; ++tok) {
    float g[16];
#pragma unroll
    for (int q = 0; q < 4; ++q) { const f32x4 t4 = *(const f32x4*)(gaL + tok * 16 + 4 * q) + *(const f32x4*)(gaL + 1024 + tok * 16 + 4 * q); g[4 * q] = t4[0]; g[4 * q + 1] = t4[1]; g[4 * q + 2] = t4[2]; g[4 * q + 3] = t4[3]; }
#pragma unroll
    for (int k = 0; k < 2; ++k) {
      float xv = bias[k];
#pragma unroll
      for (int r = 0; r < 16; ++r) xv += g[r] * w2c[k][r];
      run[k] += logsigmoid(xv) * (1.f / 16.f);
      bmat[(size_t)(r0 + tok) * 1024 + tid + 512 * k] = run[k];
    }
  }
#pragma unroll
  for (int k = 0; k < 2; ++k) eb[(size_t)item * 1024 + tid + 512 * k] = __expf(run[k]);
  __syncthreads();
}

DEV void p0_transpose8(const Params& p, int nt2, int kq) {
  const float* src; int ld, scol; bf16_t* dst;
  const int nt = nt2 * 2;
  if (nt < 352) { const int c = nt * 64; src = p.w_in; ld = 22544; scol = c + (c >= 6144 ? 16 : 0); dst = (bf16_t*)(p.ws + OFF_WT_IN) + (size_t)c * 2048; }
  else if (nt < 416) { const int c = (nt - 352) * 64; src = p.w_mkv; ld = 4096; scol = c; dst = (bf16_t*)(p.ws + OFF_WT_MKV) + (size_t)c * 2048; }
  else if (nt < 448) { const int c = (nt - 416) * 64; src = p.w_pg; ld = 2048; scol = c; dst = (bf16_t*)(p.ws + OFF_WT_PG) + (size_t)c * 2048; }
  else if (nt < 480) { const int c = (nt - 448) * 64; src = p.w_ps; ld = 2048; scol = c; dst = (bf16_t*)(p.ws + OFF_WT_PS) + (size_t)c * 2048; }
  else if (nt < 512) { const int c = (nt - 480) * 64; src = p.w_pm; ld = 2048; scol = c; dst = (bf16_t*)(p.ws + OFF_WT_PM) + (size_t)c * 2048; }
  else { const int c = (nt - 512) * 64; src = p.w_out; ld = 2048; scol = c; dst = (bf16_t*)(p.ws + OFF_WT_OUT) + (size_t)c * 2048; }
  const int t = otid();
  const int k0 = kq * 256;
  unsigned* T32 = (unsigned*)smem;
  {
    const int r2 = t >> 5, c4 = t & 31;
    const float* sp = src + (size_t)(k0 + 2 * r2) * ld + scol + 4 * c4;
    f32x4 v0[8], v1[8];
#pragma unroll
    for (int kk = 0; kk < 8; ++kk) { v0[kk] = *(const f32x4*)(sp + (size_t)(kk * 32) * ld); v1[kk] = *(const f32x4*)(sp + (size_t)(kk * 32 + 1) * ld); }
#pragma unroll
    for (int kk = 0; kk < 8; ++kk)
#pragma unroll
      for (int j = 0; j < 4; ++j) T32[(kk * 128 + 4 * c4 + j) * 17 + r2] = pk_bf16(v0[kk][j], v1[kk][j]);
  }
  __syncthreads();
  {
    const int n = t >> 2, g = t & 3;
#pragma unroll
    for (int i = 0; i < 8; ++i) {
      const int ch = g + 4 * i, kk = ch >> 2, w4 = (ch & 3) * 4;
      const unsigned* tp = T32 + (kk * 128 + n) * 17 + w4;
      const u32x4 w = {tp[0], tp[1], tp[2], tp[3]};
      *(u32x4*)(dst + (size_t)n * 2048 + k0 + 8 * ch) = w;
    }
  }
  __syncthreads();
}

DEV void phase0(const Params& p) {
  const int tidx = otid();
  unsigned* ctr = (unsigned*)(p.ws + OFF_MISC + 512);
  volatile int* slot = (volatile int*)(smem + 131072 + 2048);
  const int total = 128 + 16 + 272 * 8;
  bool first = true;
  while (true) {
    __syncthreads();
    if (tidx == 0) *slot = first ? (int)blockIdx.x : (int)(gridDim.x + atomicAdd(ctr, 1u));
    first = false;
    __syncthreads();
    const int it = __builtin_amdgcn_readfirstlane(*slot);
    if (it >= total) break;
    if (it < 128) p0_chunk(p, it);
    else if (it < 144) { norm_rows64(p.mem, p.g_mem, (bf16_t*)(p.ws + OFF_MEMH), (it - 128) * 64); }
    else { const int tt = it - 144; p0_transpose8(p, tt >> 3, tt & 7); }
  }
}

#define MKV_IN_P2 1
DEV void phase1(const Params& p, const int base_item) {
  const int nwg = MKV_IN_P2 ? 2816 : 2816 + 64;
  const int Lbeg = base_item >= 0 ? base_item : (int)blockIdx.x, Lend = base_item >= 0 ? base_item + 1 : nwg;
#pragma unroll 1
  for (int L = Lbeg; L < Lend; L += gridDim.x) {
    const bf16_t* a; const bf16_t* w; int brow, bcol; bool vt;
    EpiVT ev; EpiP1 e;
    e.bmat = (const float*)(p.ws + OFF_B); e.keT = (bf16_t*)(p.ws + OFF_KET); e.ld = 2048; e.scale = 1.f; e.mode = 0; e.out = nullptr; e.segstart = 0;
    ev.out = nullptr; ev.nch = 2048; ev.tshift = 11; ev.segstart = 0;
    if (L < 2816) {
      const int xcd = L & 7, off = L >> 3, wgid = xcd * 352 + off;
      const int nig = 8 * 88, gid = wgid / nig, pm = gid * 8 + (wgid % nig) % 8, pn = (wgid % nig) / 8;
      brow = pm * 256; bcol = pn * 256;
      a = (const bf16_t*)(p.ws + OFF_H); w = (const bf16_t*)(p.ws + OFF_WT_IN);
      vt = (bcol >= 2048 && bcol < 4096) || (bcol >= 10240 && bcol < 12288);
      if (vt) {
        if (bcol < 4096) { ev.out = (bf16_t*)(p.ws + OFF_GVT); ev.segstart = 2048; } else { ev.out = (bf16_t*)(p.ws + OFF_SVT); ev.segstart = 10240; }
      } else {
        if (bcol < 1024) { e.mode = 3; e.out = (bf16_t*)(p.ws + OFF_QP); e.segstart = 0; e.scale = 1.f / 16.f; e.ld = 1024; }
        else if (bcol < 2048) { e.mode = 4; e.out = (bf16_t*)(p.ws + OFF_KDP); e.segstart = 1024; e.ld = 1024; }
        else if (bcol < 6144) { e.mode = 1; e.out = (bf16_t*)(p.ws + OFF_SGG); e.segstart = 4096; }
        else if (bcol < 8192) { e.mode = 0; e.out = (bf16_t*)(p.ws + OFF_SQ); e.segstart = 6144; e.scale = 0.08838834764831845f * 1.4426950408889634f; }
        else if (bcol < 10240) { e.mode = 0; e.out = (bf16_t*)(p.ws + OFF_SK); e.segstart = 8192; }
        else if (bcol < 14336) { e.mode = 1; e.out = (bf16_t*)(p.ws + OFF_SSG); e.segstart = 12288; }
        else if (bcol < 16384) { e.mode = 0; e.out = (bf16_t*)(p.ws + OFF_MQ); e.segstart = 14336; e.scale = 0.04419417382415922f; }
        else { e.mode = 2; e.out = (bf16_t*)(p.ws + OFF_GATES); e.segstart = 16384; e.ld = 6144; }
      }
    } else {
      const int l = L - 2816, pm = l & 3, pn = l >> 2;
      brow = pm * 256; bcol = pn * 256;
      a = (const bf16_t*)(p.ws + OFF_MEMH); w = (const bf16_t*)(p.ws + OFF_WT_MKV);
      vt = bcol >= 2048;
      if (vt) { ev.out = (bf16_t*)(p.ws + OFF_MVT); ev.tshift = 8; ev.segstart = 2048; }
      else { e.mode = 0; e.out = (bf16_t*)(p.ws + OFF_MK); }
    }
    if (vt) gemm_tile<false>(a, w, 2048, brow, bcol, ev);
    else gemm_tile<true>(a, w, 2048, brow, bcol, e);
  }
}

DEV void panel_publish(unsigned* cnt, const int tidx) {
  asm volatile("s_waitcnt vmcnt(0)" ::: "memory");
  __syncthreads();
  if (tidx == 0) {
    __builtin_amdgcn_fence(__ATOMIC_RELEASE, "agent");
    asm volatile("s_waitcnt vmcnt(0)" ::: "memory");
    __hip_atomic_fetch_add(cnt, 1u, __ATOMIC_RELAXED, __HIP_MEMORY_SCOPE_AGENT);
  }
}
DEV void panel_wait(unsigned* cnt, const unsigned need, const int tidx) {
  if (tidx == 0) {
    while (__hip_atomic_load(cnt, __ATOMIC_RELAXED, __HIP_MEMORY_SCOPE_AGENT) < need) __builtin_amdgcn_s_sleep(2);
    __builtin_amdgcn_fence(__ATOMIC_ACQUIRE, "agent");
    asm volatile("s_waitcnt vmcnt(0)" ::: "memory");
  }
  __syncthreads();
}
#define GLDS16(src_, dst_) __builtin_amdgcn_global_load_lds((const unsigned*)(src_), (unsigned*)(dst_), 16, 0, 0)

DEV void gla_block(const Params& p, int g) {
  const int tidx = otid();
  const int wave = __builtin_amdgcn_readfirstlane(tidx >> 6), lane = tidx & 63, l31 = lane & 31, hh = lane >> 5;
  const int bh = g >> 2, b = bh >> 2, h = bh & 3, dkh = wave >> 2, vs = (g & 3) * 4 + (wave & 3);
  const bf16_t* Qp = (const bf16_t*)(p.ws + OFF_QP);
  const bf16_t* KeT = (const bf16_t*)(p.ws + OFF_KET);
  const bf16_t* gvT = (const bf16_t*)(p.ws + OFF_GVT);
  const float* eb = (const float*)(p.ws + OFF_EB);
  f32x16 S[4];
#pragma unroll
  for (int t = 0; t < 4; ++t) for (int gg = 0; gg < 16; ++gg) S[t][gg] = 0.f;
  const bf16_t* vrow = gvT + ((size_t)(b * 2048 + h * 512 + vs * 32 + l31)) * 2048 + 8 * hh;
  const bf16_t* qsrc; const bf16_t* ksrc;
  {
    const int rq = lane >> 5, pq = lane & 31;
    const int rk = lane >> 3, pk = lane & 7;
    qsrc = Qp + ((size_t)b * 2048 + rq) * 1024 + h * 256;
    ksrc = KeT + ((size_t)((b * 4 + h) * 256 + rk)) * 2048;
    (void)pq; (void)pk;
  }
#define GLA_DMA(c_, buf_) do { const int tok0_ = (c_) * 64; \
    _Pragma("unroll") for (int i_ = 0; i_ < 8; ++i_) { const int k_ = wave * 8 + i_; \
      if (k_ < 32) { const int r_ = 2 * k_ + (lane >> 5); \
        GLDS16(qsrc + (size_t)(tok0_ + 2 * k_) * 1024 + (((lane & 31) ^ (r_ & 31)) * 8), smem + (buf_) * 65536 + k_ * 1024 + lane * 16); } \
      else { const int kk_ = k_ - 32, r_ = 8 * kk_ + (lane >> 3); \
        GLDS16(ksrc + (size_t)(8 * kk_) * 2048 + tok0_ + (((lane & 7) ^ ((r_ >> 1) & 7)) * 8), smem + (buf_) * 65536 + 32768 + kk_ * 1024 + lane * 16); } } } while (0)
#define GLA_EB(c_, buf_) do { if (wave == 0) GLDS16(eb + (size_t)(b * 32 + (c_)) * 1024 + h * 256 + lane * 4, smem + 131072 + (buf_) * 1024 + lane * 16); } while (0)
  const int Q0 = l31 * 512 + (((16 * dkh + hh) ^ l31) * 16);
  const int K0 = 32768 + (128 * dkh + l31) * 128 + ((hh ^ ((l31 >> 1) & 7)) * 16);
  asm volatile("s_waitcnt vmcnt(0)" ::: "memory");
  __syncthreads();
  GLA_DMA(0, 0); GLA_EB(0, 0);
  bf16x8 vf[4], vfn[4];
#pragma unroll
  for (int s4 = 0; s4 < 4; ++s4) { vf[s4] = ld16(vrow + 16 * s4); vfn[s4] = vf[s4]; }
  asm volatile("s_waitcnt vmcnt(0)" ::: "memory");
  __syncthreads();
#pragma unroll 1
  for (int c = 0; c < 32; ++c) {
    const int tok0 = c * 64, buf = c & 1;
    const size_t grow = (size_t)b * 2048 + tok0;
    if (c + 1 < 32) {
      GLA_DMA(c + 1, buf ^ 1); GLA_EB(c + 1, buf ^ 1);
#pragma unroll
      for (int s4 = 0; s4 < 4; ++s4) vfn[s4] = ld16(vrow + tok0 + 64 + 16 * s4);
    }
    const char* lq = smem + buf * 65536;
    int q0v = Q0, k0v = K0;
    asm volatile("" : "+v"(q0v), "+v"(k0v));
    f32x16 o0, o1;
    for (int gg = 0; gg < 16; ++gg) { o0[gg] = 0.f; o1[gg] = 0.f; }
#pragma unroll
    for (int th = 0; th < 2; ++th) {
      bf16x8 qa[2][2], qb_[2][2];
#pragma unroll
      for (int t = 0; t < 2; ++t)
#pragma unroll
        for (int s = 0; s < 2; ++s) { qa[t][s] = *(const bf16x8*)(lq + (q0v ^ (64 * (2 * th + t) + 32 * s))); qb_[t][s] = *(const bf16x8*)(lq + (q0v ^ (64 * (2 * th + t) + 32 * s)) + 32 * 512); }
      __builtin_amdgcn_sched_barrier(0);
#pragma unroll
      for (int t = 0; t < 2; ++t) {
        const bf16x8 s0 = cvt8<0>(S[2 * th + t]), s1 = cvt8<1>(S[2 * th + t]);
        o0 = mfma32(s0, qa[t][0], o0); o1 = mfma32(s0, qb_[t][0], o1);
        o0 = mfma32(s1, qa[t][1], o0); o1 = mfma32(s1, qb_[t][1], o1);
      }
      __builtin_amdgcn_sched_barrier(0);
    }
    {
      const float* ebl = (const float*)(smem + 131072 + buf * 1024) + dkh * 128 + 4 * hh;
#pragma unroll
      for (int t = 0; t < 4; ++t)
#pragma unroll
        for (int q = 0; q < 4; ++q) { const f32x4 e4 = *(const f32x4*)(ebl + 32 * t + 8 * q); for (int j = 0; j < 4; ++j) S[t][4 * q + j] *= e4[j]; }
#pragma unroll
      for (int sh = 0; sh < 2; ++sh) {
        bf16x8 kf[4][2];
#pragma unroll
        for (int t = 0; t < 4; ++t)
#pragma unroll
          for (int s = 0; s < 2; ++s) kf[t][s] = *(const bf16x8*)(lq + (k0v ^ (32 * (2 * sh + s))) + t * 4096);
        __builtin_amdgcn_sched_barrier(0);
#pragma unroll
        for (int s = 0; s < 2; ++s)
#pragma unroll
          for (int t = 0; t < 4; ++t) S[t] = mfma32(kf[t][s], vf[2 * sh + s], S[t]);
        __builtin_amdgcn_sched_barrier(0);
      }
    }
#pragma unroll
    for (int s4 = 0; s4 < 4; ++s4) vf[s4] = vfn[s4];
    u32x2* xch = (u32x2*)(smem + 135168) + (wave & 3) * 512 + lane;
    __syncthreads();
    if (dkh == 1) {
#pragma unroll
      for (int q = 0; q < 4; ++q) {
        const f32x4 a0 = {o0[4 * q], o0[4 * q + 1], o0[4 * q + 2], o0[4 * q + 3]}, a1 = {o1[4 * q], o1[4 * q + 1], o1[4 * q + 2], o1[4 * q + 3]};
        xch[q * 64] = pk4(a0); xch[(4 + q) * 64] = pk4(a1);
      }
    }
    asm volatile("s_waitcnt vmcnt(0)" ::: "memory");
    __syncthreads();
    if (dkh == 0) {
      u32x2* o_ = (u32x2*)(p.ws + OFF_OP0) + ((((size_t)((b * 32 + c) * 4 + h) * 16 + vs) * 2) * 4) * 64 + lane;
#pragma unroll
      for (int q = 0; q < 4; ++q) {
        const f32x4 a0 = {o0[4 * q], o0[4 * q + 1], o0[4 * q + 2], o0[4 * q + 3]}, a1 = {o1[4 * q], o1[4 * q + 1], o1[4 * q + 2], o1[4 * q + 3]};
        o_[q * 64] = pk4(a0 + unpk4(xch[q * 64])); o_[(4 + q) * 64] = pk4(a1 + unpk4(xch[(4 + q) * 64]));
      }
    }
  }
  asm volatile("s_waitcnt vmcnt(0)" ::: "memory");
  __syncthreads();
#undef GLA_EB
#undef GLA_DMA
  panel_publish((unsigned*)(p.ws + OFF_MISC + 2048 + 768) + bh, tidx);
}

template <bool DIAG>
DEV void sb_tile(const char* lk, const char* lv, const int ko0, const int vo0, const bf16x8 (&qf)[8], f32x16 (&O)[4], float& accp,
                 const int l31, const int hh) {
  f32x16 z;
  for (int g = 0; g < 16; ++g) z[g] = 0.f;
  {
    bf16x8 kf[8];
#pragma unroll
    for (int s = 0; s < 8; ++s) kf[s] = *(const bf16x8*)(lk + (ko0 ^ (32 * s)));
    __builtin_amdgcn_sched_barrier(0);
#pragma unroll
    for (int s = 0; s < 8; ++s) z = mfma32(kf[s], qf[s], z);
  }
  bf16x8 vf[4][2];
#pragma unroll
  for (int d = 0; d < 4; ++d) { vf[d][0] = *(const bf16x8*)(lv + d * 4096 + vo0); vf[d][1] = *(const bf16x8*)(lv + d * 4096 + (vo0 ^ 32)); }
  __builtin_amdgcn_sched_barrier(0);
  float be[16], om[16];
#pragma unroll
  for (int g = 0; g < 16; ++g) {
    const float e = __builtin_amdgcn_exp2f(fminf(-z[g], 120.f));
    be[g] = __builtin_amdgcn_rcpf(1.f + e);
    om[g] = e * be[g];
    if (DIAG) { const int kl = (g & 3) + 8 * (g >> 2) + 4 * hh; if (kl >= l31) { be[g] = 0.f; om[g] = 1.f; } }
  }
  float gp[4], pp[4], tot[4];
#pragma unroll
  for (int q = 0; q < 4; ++q) { gp[q] = (om[4 * q] * om[4 * q + 1]) * (om[4 * q + 2] * om[4 * q + 3]); pp[q] = __shfl_xor(gp[q], 32); tot[q] = gp[q] * pp[q]; }
  float suf[4];
  suf[3] = accp; suf[2] = suf[3] * tot[3]; suf[1] = suf[2] * tot[2]; suf[0] = suf[1] * tot[1];
  accp = suf[0] * tot[0];
  f32x16 w;
#pragma unroll
  for (int q = 0; q < 4; ++q) {
    float a = suf[q] * (hh == 0 ? pp[q] : 1.f);
    w[4 * q + 3] = be[4 * q + 3] * a; a *= om[4 * q + 3];
    w[4 * q + 2] = be[4 * q + 2] * a; a *= om[4 * q + 2];
    w[4 * q + 1] = be[4 * q + 1] * a; a *= om[4 * q + 1];
    w[4 * q + 0] = be[4 * q + 0] * a;
  }
  const bf16x8 w0 = cvt8<0>(w), w1 = cvt8<1>(w);
#pragma unroll
  for (int d = 0; d < 4; ++d) { O[d] = mfma32(vf[d][0], w0, O[d]); O[d] = mfma32(vf[d][1], w1, O[d]); }
}

DEV void sb_block(const Params& p, int item) {
  const int tidx = otid();
  const int wave = __builtin_amdgcn_readfirstlane(tidx >> 6), lane = tidx & 63, l31 = lane & 31, hh = lane >> 5;
  const int qb = 7 - (item >> 6), bh = item & 63, b = bh >> 4, h = bh & 15;
  const int qt = 8 * qb + wave;
  const bf16_t* sq = (const bf16_t*)(p.ws + OFF_SQ);
  const bf16_t* sk = (const bf16_t*)(p.ws + OFF_SK);
  const bf16_t* svT = (const bf16_t*)(p.ws + OFF_SVT);
  const bf16_t* ssg = (const bf16_t*)(p.ws + OFF_SSG);
  bf16_t* ob = (bf16_t*)(p.ws + OFF_OB);
  const size_t row0 = (size_t)b * 2048;
  bf16x8 qf[8];
  {
    const bf16_t* qp = sq + (row0 + qt * 32 + l31) * 2048 + h * 128 + 8 * hh;
#pragma unroll
    for (int s = 0; s < 8; ++s) qf[s] = ld16(qp + 16 * s);
  }
  f32x16 O[4];
#pragma unroll
  for (int d = 0; d < 4; ++d) for (int g = 0; g < 16; ++g) O[d][g] = 0.f;
  float accp = 1.f;
  const bf16_t* ksrc = sk + (row0 + (lane >> 4)) * 2048 + h * 128;
  const bf16_t* vsrc = svT + ((size_t)(b * 2048 + h * 128 + (lane >> 3))) * 2048;
#define SB_DMA(j_, buf_) do { \
    _Pragma("unroll") for (int i_ = 0; i_ < 4; ++i_) { const int k_ = wave * 4 + i_; \
      if (k_ < 16) { const int r_ = 4 * k_ + (lane >> 4); \
        GLDS16(ksrc + (size_t)(64 * (j_) + 4 * k_) * 2048 + (((lane & 15) ^ (r_ & 15)) * 8), smem + (buf_) * 32768 + k_ * 1024 + lane * 16); } \
      else { const int kk_ = k_ - 16, r_ = 8 * kk_ + (lane >> 3); \
        GLDS16(vsrc + (size_t)(8 * kk_) * 2048 + 64 * (j_) + (((lane & 7) ^ ((r_ >> 1) & 7)) * 8), smem + (buf_) * 32768 + 16384 + kk_ * 1024 + lane * 16); } } } while (0)
  const int KO0 = l31 * 256 + ((hh ^ (l31 & 15)) * 16);
  const int VO0 = 16384 + l31 * 128 + ((hh ^ ((l31 >> 1) & 7)) * 16);
  const int nsteps = 4 * qb + 4;
  asm volatile("s_waitcnt vmcnt(0)" ::: "memory");
  __syncthreads();
  { const int j0 = nsteps - 1; SB_DMA(j0, 0); SB_DMA((j0 > 0 ? j0 - 1 : 0), 1); SB_DMA((j0 > 1 ? j0 - 2 : 0), 2); }
#pragma unroll 1
  for (int n = 0; n < nsteps; ++n) {
    const int j = nsteps - 1 - n, buf = n & 3;
    asm volatile("s_waitcnt vmcnt(8)" ::: "memory");
    __builtin_amdgcn_s_barrier();
    asm volatile("" ::: "memory");
    { const int jn = j > 3 ? j - 3 : 0; SB_DMA(jn, (n + 3) & 3); }
    const char* lb_ = smem + buf * 32768;
    int ko0 = KO0, vo0 = VO0;
    asm volatile("" : "+v"(ko0), "+v"(vo0));
    if (2 * j + 1 == qt) sb_tile<true>(lb_ + 32 * 256, lb_, ko0, vo0 ^ 64, qf, O, accp, l31, hh);
    else if (2 * j + 1 < qt) sb_tile<false>(lb_ + 32 * 256, lb_, ko0, vo0 ^ 64, qf, O, accp, l31, hh);
    if (2 * j == qt) sb_tile<true>(lb_, lb_, ko0, vo0, qf, O, accp, l31, hh);
    else if (2 * j < qt) sb_tile<false>(lb_, lb_, ko0, vo0, qf, O, accp, l31, hh);
    asm volatile("" ::: "memory");
  }
  asm volatile("s_waitcnt vmcnt(0)" ::: "memory");
#undef SB_DMA
  __syncthreads();
  {
    char* lw = smem + wave * 16384;
#pragma unroll
    for (int d = 0; d < 4; ++d)
#pragma unroll
      for (int q = 0; q < 4; ++q) {
        const f32x4 o = {O[d][4 * q], O[d][4 * q + 1], O[d][4 * q + 2], O[d][4 * q + 3]};
        *(f32x4*)(lw + l31 * 512 + (((8 * d + 2 * q + hh) ^ l31) * 16)) = o;
      }
    asm volatile("s_waitcnt lgkmcnt(0)" ::: "memory");
    const size_t tok0 = row0 + qt * 32;
    u32x2 gv[16];
#pragma unroll
    for (int i = 0; i < 16; ++i) { const int r = 2 * i + hh, c = l31 ^ r; gv[i] = *(const u32x2*)(ssg + (tok0 + r) * 2048 + h * 128 + 4 * c); }
#pragma unroll
    for (int i = 0; i < 16; ++i) {
      const int r = 2 * i + hh, c = l31 ^ r;
      const f32x4 o = *(const f32x4*)(lw + r * 512 + l31 * 16);
      *(u32x2*)(ob + (tok0 + r) * 2048 + h * 128 + 4 * c) = pk4(o * unpk4(gv[i]));
    }
  }
  panel_publish((unsigned*)(p.ws + OFF_MISC + 2048 + 896) + (b * 8 + qb), tidx);
  __syncthreads();
}

DEV void mem_block(const Params& p, int item) {
  const int tidx = otid();
  const int wave = __builtin_amdgcn_readfirstlane(tidx >> 6), lane = tidx & 63, l31 = lane & 31, hh = lane >> 5;
  const int h = item & 3, qblk = item >> 2, qt = qblk * 8 + wave, b = qblk >> 3;
  const size_t tok = (size_t)qt * 32 + l31;
  const bf16_t* qp = (const bf16_t*)(p.ws + OFF_MQ) + tok * 2048 + h * 512 + 8 * hh;
  const bf16_t* ksrc = (const bf16_t*)(p.ws + OFF_MK) + ((size_t)(b * 256 + (lane >> 3))) * 2048 + h * 512;
  const bf16_t* vsrc = (const bf16_t*)(p.ws + OFF_MVT) + ((size_t)(b * 2048 + h * 512 + (lane >> 5))) * 256;
  bf16_t* om = (bf16_t*)(p.ws + OFF_OM);
#define MEM_DMA(n_, buf_) do { \
    _Pragma("unroll") for (int i_ = 0; i_ < 4; ++i_) { const int k_ = wave * 4 + i_; \
      if ((n_) < 8) { const int r_ = 8 * k_ + (lane >> 3); \
        GLDS16(ksrc + (size_t)(8 * k_) * 2048 + 64 * (n_) + (((lane & 7) ^ ((r_ >> 1) & 7)) * 8), smem + (buf_) * 32768 + k_ * 1024 + lane * 16); } \
      else { const int r_ = 2 * k_ + (lane >> 5); \
        GLDS16(vsrc + (size_t)(64 * ((n_) - 8) + 2 * k_) * 256 + (((lane & 31) ^ (r_ & 31)) * 8), smem + (buf_) * 32768 + k_ * 1024 + lane * 16); } } } while (0)
  const int KF0 = l31 * 128 + ((hh ^ ((l31 >> 1) & 7)) * 16);
  f32x16 Sx[8];
#pragma unroll
  for (int t = 0; t < 8; ++t) for (int g = 0; g < 16; ++g) Sx[t][g] = 0.f;
  asm volatile("s_waitcnt vmcnt(0)" ::: "memory");
  __syncthreads();
  bf16x8 bq[3][4];
#pragma unroll
  for (int kq = 0; kq < 4; ++kq) bq[0][kq] = ld16(qp + 16 * kq);
  MEM_DMA(0, 0);
#pragma unroll
  for (int kq = 0; kq < 4; ++kq) bq[1][kq] = ld16(qp + 64 + 16 * kq);
  MEM_DMA(1, 1);
#pragma unroll
  for (int n = 0; n < 8; ++n) {
    const int buf = n % 3, nb = (n + 2) % 3;
    asm volatile("s_waitcnt vmcnt(8)" ::: "memory");
    __builtin_amdgcn_s_barrier();
    asm volatile("" ::: "memory");
    {
      const int nq = n + 2 < 8 ? n + 2 : 7;
#pragma unroll
      for (int kq = 0; kq < 4; ++kq) bq[nb][kq] = ld16(qp + 64 * nq + 16 * kq);
    }
    MEM_DMA(n + 2, nb);
    const char* lf = smem + buf * 32768;
    int kf0 = KF0;
    asm volatile("" : "+v"(kf0));
#pragma unroll
    for (int kq = 0; kq < 4; ++kq) {
      bf16x8 kf[8];
#pragma unroll
      for (int t = 0; t < 8; ++t) kf[t] = *(const bf16x8*)(lf + t * 4096 + (kf0 ^ (32 * kq)));
      __builtin_amdgcn_sched_barrier(0);
#pragma unroll
      for (int t = 0; t < 8; ++t) Sx[t] = mfma32(kf[t], bq[buf][kq], Sx[t]);
    }
    asm volatile("" ::: "memory");
  }
  int buf = 8 % 3;
  float mx = -1e30f;
#pragma unroll
  for (int t = 0; t < 8; ++t) for (int g = 0; g < 16; ++g) mx = fmaxf(mx, Sx[t][g]);
  mx = fmaxf(mx, __shfl_xor(mx, 32));
  float sum = 0.f;
#pragma unroll
  for (int t = 0; t < 8; ++t) for (int g = 0; g < 16; ++g) { const float e = __expf(Sx[t][g] - mx); Sx[t][g] = e; sum += e; }
  sum += __shfl_xor(sum, 32);
  const float inv = 1.f / sum;
  bf16x8 pf[8][2];
#pragma unroll
  for (int t = 0; t < 8; ++t) { pf[t][0] = cvt8<0>(Sx[t]); pf[t][1] = cvt8<1>(Sx[t]); }
  const int VF0 = l31 * 512 + ((hh ^ l31) * 16);
#pragma unroll 1
  for (int n = 8; n < 16; ++n) {
    if (n == 8) asm volatile("s_waitcnt vmcnt(4)" ::: "memory");
    else if (n == 9) asm volatile("s_waitcnt vmcnt(8)" ::: "memory");
    else asm volatile("s_waitcnt vmcnt(12)" ::: "memory");
    __builtin_amdgcn_s_barrier();
    asm volatile("" ::: "memory");
    const int nb = buf >= 1 ? buf - 1 : 2;
    { const int nn = n + 2 < 16 ? n + 2 : 15; MEM_DMA(nn, nb); }
    const char* lf = smem + buf * 32768;
    int vf0 = VF0;
    asm volatile("" : "+v"(vf0));
    char* lw = smem + 98304 + wave * 4096;
#pragma unroll
    for (int dd = 0; dd < 2; ++dd) {
      f32x16 o;
      for (int g = 0; g < 16; ++g) o[g] = 0.f;
#pragma unroll
      for (int t = 0; t < 8; ++t) { o = mfma32(*(const bf16x8*)(lf + dd * 16384 + (vf0 ^ (64 * t))), pf[t][0], o); o = mfma32(*(const bf16x8*)(lf + dd * 16384 + (vf0 ^ (64 * t + 32))), pf[t][1], o); }
#pragma unroll
      for (int q = 0; q < 4; ++q) {
        f32x4 v = {o[4 * q] * inv, o[4 * q + 1] * inv, o[4 * q + 2] * inv, o[4 * q + 3] * inv};
        *(u32x2*)(lw + l31 * 128 + (((4 * dd + q) ^ (l31 & 7)) * 16) + hh * 8) = pk4(v);
      }
    }
    asm volatile("s_waitcnt lgkmcnt(0)" ::: "memory");
#pragma unroll
    for (int i = 0; i < 4; ++i) {
      const int id = i * 64 + lane, r = id >> 3, pos = id & 7, c = pos ^ (r & 7);
      *(u32x4*)(om + ((size_t)qt * 32 + r) * 2048 + h * 512 + 64 * (n - 8) + 8 * c) = *(const u32x4*)(lw + r * 128 + pos * 16);
    }
    buf = buf == 2 ? 0 : buf + 1;
    asm volatile("" ::: "memory");
  }
#undef MEM_DMA
  panel_publish((unsigned*)(p.ws + OFF_MISC + 2048 + 896) + qblk, tidx);
  __syncthreads();
}

DEV void phase2(const Params& p, int rerun) {
  const int tidx = otid();
  const int parts = rerun ? PROBE_PART : 7;
  if (parts & 1) for (int g = blockIdx.x; g < 64; g += gridDim.x) gla_block(p, g);
  unsigned* ctr = (unsigned*)(p.ws + OFF_MISC + (rerun ? 256 : 0));
  volatile int* slot = (volatile int*)(smem + 131072 + 2048);
  unsigned* mkv_done = (unsigned*)(p.ws + OFF_MISC + 1024);
  const int nstatic = ((parts & 1) && gridDim.x > 64) ? (int)gridDim.x - 64 : ((parts & 1) ? 0 : (int)gridDim.x);
  bool first = ((parts & 1) ? (int)blockIdx.x >= 64 && nstatic > 0 : true);
  const int firstit = (parts & 1) ? (int)blockIdx.x - 64 : (int)blockIdx.x;
  const bool xq = (parts == 7) && (gridDim.x == 256);
  const int xcd = (int)blockIdx.x & 7;
  unsigned* ctrx = (unsigned*)(p.ws + OFF_MISC + 1536 + xcd * 64);
  while (true) {
    __syncthreads();
    if (tidx == 0) {
      if (!xq) *slot = first ? firstit : (int)(nstatic + atomicAdd(ctr, 1u));
      else {
        const int i = first ? (firstit >> 3) : (int)(24 + atomicAdd(ctrx, 1u));
        int g;
        if (i < 8) g = i * 8 + xcd;
        else if (i < 48) { const int s_ = i - 8; g = 64 + (s_ >> 3) * 64 + ((s_ & 7) * 8 + xcd); }
        else if (i < 64) g = 64 + 320 + (i - 48) * 8 + xcd;
        else if (i < 88) { const int s_ = i - 64 + 40; g = 64 + 128 + (s_ >> 3) * 64 + ((s_ & 7) * 8 + xcd); }
        else g = 64 + 512 + 128;
        *slot = g;
      }
    }
    first = false;
    __syncthreads();
    const int it = __builtin_amdgcn_readfirstlane(*slot);
    if (it >= 64 + 512 + 128) break;
    if (it < 64) {
      phase1(p, 2816 + it);
      __threadfence();
      __syncthreads();
      if (tidx == 0) atomicAdd(mkv_done, 1u);
    } else if (it < 64 + 320) { if (parts & 2) sb_block(p, it - 64); }
    else if (it >= 64 + 320 + 128) { if (parts & 2) sb_block(p, it - 64 - 128); }
    else {
      if (tidx == 0) {
        while (__hip_atomic_load(mkv_done, __ATOMIC_RELAXED, __HIP_MEMORY_SCOPE_AGENT) < 64u) __builtin_amdgcn_s_sleep(8);
        __builtin_amdgcn_fence(__ATOMIC_ACQUIRE, "agent");
      }
      __syncthreads();
      if (parts & 4) mem_block(p, it - 64 - 320);
    }
  }
}

DEV void phase25(const Params& p, const bool fuse) {
  const int tidx = otid();
  const int wave = __builtin_amdgcn_readfirstlane(tidx >> 6), lane = tidx & 63, l31 = lane & 31, hh = lane >> 5;
  const bf16_t* Qp = (const bf16_t*)(p.ws + OFF_QP);
  const bf16_t* Kd = (const bf16_t*)(p.ws + OFF_KDP);
  const bf16_t* gvT = (const bf16_t*)(p.ws + OFF_GVT);
  const bf16_t* sgg = (const bf16_t*)(p.ws + OFF_SGG);
  const float* op0 = (const float*)(p.ws + OFF_OP0);
  const float* op1 = (const float*)(p.ws + OFF_OP1);
  bf16_t* oa = (bf16_t*)(p.ws + OFF_OA);
  float* ssL = (float*)(smem + 131072 + 3072);
  unsigned* ctr25 = (unsigned*)(p.ws + OFF_MISC + 1280);
  volatile int* slot25 = (volatile int*)(smem + 131072 + 2048);
  int itn = blockIdx.x;
#pragma unroll 1
  for (;;) {
    int it;
    if (fuse) {
      __syncthreads();
      if (tidx == 0) *slot25 = (int)atomicAdd(ctr25, 1u);
      __syncthreads();
      it = __builtin_amdgcn_readfirstlane(*slot25);
    } else { it = itn; itn += gridDim.x; }
    if (it >= 512) break;
    const int bh = it >> 5, c = it & 31, b = bh >> 2, h = bh & 3, tok0 = c * 64;
    const size_t grow = (size_t)b * 2048 + tok0;
    if (fuse) panel_wait((unsigned*)(p.ws + OFF_MISC + 2048 + 768) + bh, 4u, tidx);
    if (tidx < 64) ssL[tidx] = 0.f;
    if (wave < 3) {
      const int jt = (wave == 2) ? 1 : 0, i2 = (wave == 0) ? 0 : 1;
      const bf16_t* kd = Kd + (grow + 32 * jt + l31) * 1024 + h * 256 + 8 * hh;
      const bf16_t* q = Qp + (grow + 32 * i2 + l31) * 1024 + h * 256 + 8 * hh;
      f32x16 X;
      for (int g = 0; g < 16; ++g) X[g] = 0.f;
#pragma unroll
      for (int s = 0; s < 16; ++s) X = mfma32(ld16(kd + 16 * s), ld16(q + 16 * s), X);
      if (jt == i2) {
#pragma unroll
        for (int g = 0; g < 16; ++g) { const int jl = (g & 3) + 8 * (g >> 2) + 4 * hh; if (jl > l31) X[g] = 0.f; }
      }
      *(bf16x8*)(smem + (wave * 2 + 0) * 1024 + lane * 16) = cvt8<0>(X);
      *(bf16x8*)(smem + (wave * 2 + 1) * 1024 + lane * 16) = cvt8<1>(X);
    }
    f32x16 o[2][2];
#pragma unroll
    for (int dt = 0; dt < 2; ++dt)
#pragma unroll
      for (int i2 = 0; i2 < 2; ++i2)
#pragma unroll
        for (int q = 0; q < 4; ++q) {
          const size_t idx = ((((size_t)((b * 32 + c) * 4 + h) * 16 + (2 * wave + dt)) * 2 + i2) * 4 + q) * 64 + lane;
          const f32x4 a = unpk4(((const u32x2*)op0)[idx]);
          for (int j = 0; j < 4; ++j) o[dt][i2][4 * q + j] = a[j];
        }
    bf16x8 vfr[2][4];
#pragma unroll
    for (int dt = 0; dt < 2; ++dt)
#pragma unroll
      for (int s4 = 0; s4 < 4; ++s4) vfr[dt][s4] = ld16(gvT + ((size_t)(b * 2048 + h * 512 + 64 * wave + 32 * dt + l31)) * 2048 + tok0 + 16 * s4 + 8 * hh);
    __syncthreads();
    {
      const char* lx = smem + lane * 16;
      const bf16x8 x00a = *(const bf16x8*)(lx), x00b = *(const bf16x8*)(lx + 1024), x01a = *(const bf16x8*)(lx + 2048), x01b = *(const bf16x8*)(lx + 3072),
                   x11a = *(const bf16x8*)(lx + 4096), x11b = *(const bf16x8*)(lx + 5120);
#pragma unroll
      for (int dt = 0; dt < 2; ++dt) {
        o[dt][0] = mfma32(vfr[dt][0], x00a, o[dt][0]); o[dt][0] = mfma32(vfr[dt][1], x00b, o[dt][0]);
        o[dt][1] = mfma32(vfr[dt][0], x01a, o[dt][1]); o[dt][1] = mfma32(vfr[dt][1], x01b, o[dt][1]);
        o[dt][1] = mfma32(vfr[dt][2], x11a, o[dt][1]); o[dt][1] = mfma32(vfr[dt][3], x11b, o[dt][1]);
      }
    }
#pragma unroll
    for (int i2 = 0; i2 < 2; ++i2) {
      float ss = 0.f;
#pragma unroll
      for (int dt = 0; dt < 2; ++dt) for (int g = 0; g < 16; ++g) ss += o[dt][i2][g] * o[dt][i2][g];
      ss += __shfl_xor(ss, 32);
      if (hh == 0) atomicAdd(&ssL[32 * i2 + l31], ss);
    }
    __syncthreads();
    {
      char* lw = smem + wave * 16384;
#pragma unroll
      for (int dt = 0; dt < 2; ++dt)
#pragma unroll
        for (int i2 = 0; i2 < 2; ++i2)
#pragma unroll
          for (int q = 0; q < 4; ++q) {
            const f32x4 v = {o[dt][i2][4 * q], o[dt][i2][4 * q + 1], o[dt][i2][4 * q + 2], o[dt][i2][4 * q + 3]};
            const int r = 32 * i2 + l31;
            *(f32x4*)(lw + r * 256 + (((8 * dt + 2 * q + hh) ^ (r & 15)) * 16)) = v;
          }
      asm volatile("s_waitcnt lgkmcnt(0)" ::: "memory");
      u32x2 sgv[16]; f32x4 ghv[16];
#pragma unroll
      for (int i = 0; i < 16; ++i) {
        const int id = i * 64 + lane, r = id >> 4, pos = id & 15, c = pos ^ (r & 15);
        const int dv = 64 * wave + 4 * c;
        sgv[i] = *(const u32x2*)(sgg + (grow + r) * 2048 + h * 512 + dv);
        ghv[i] = *(const f32x4*)(p.g_head + dv);
      }
#pragma unroll
      for (int i = 0; i < 16; ++i) {
        const int id = i * 64 + lane, r = id >> 4, pos = id & 15, c = pos ^ (r & 15);
        const f32x4 v = *(const f32x4*)(lw + r * 256 + pos * 16);
        const float rstd = rsqrtf(ssL[r] * (1.f / 512.f) + 1e-6f);
        const int dv = 64 * wave + 4 * c;
        *(u32x2*)(oa + (grow + r) * 2048 + h * 512 + dv) = pk4(v * rstd * ghv[i] * unpk4(sgv[i]));
      }
    }
    __syncthreads();
    if (fuse) panel_publish((unsigned*)(p.ws + OFF_MISC + 2048 + 512) + (b * 8 + (c >> 2)), tidx);
  }
}

DEV void phase3(const Params& p, const bool fuse) {
  EpiMerge e; e.gates = (const bf16_t*)(p.ws + OFF_GATES); e.mg = (float*)(p.ws + OFF_MERGED); e.mbf = (bf16_t*)(p.ws + OFF_MBF);
  unsigned* cnt3 = (unsigned*)(p.ws + OFF_MISC + 2048 + 256);
  for (int L = blockIdx.x; L < 256; L += gridDim.x) {
    const int xcd = L & 7, off = L >> 3, wgid = xcd * 32 + off;
    const int pm = wgid >> 3, pn = wgid & 7;
    const int brow = pm * 256, bcol = pn * 256;
#pragma unroll 1
    for (int step = 0; step < 3; ++step) {
      const bf16_t* a = (const bf16_t*)(p.ws + (step == 0 ? OFF_OB : step == 1 ? OFF_OM : OFF_OA));
      const bf16_t* w = (const bf16_t*)(p.ws + (step == 0 ? OFF_WT_PS : step == 1 ? OFF_WT_PM : OFF_WT_PG));
      if (fuse && step == 0) panel_wait((unsigned*)(p.ws + OFF_MISC + 2048 + 896) + pm, 20u, otid());
      if (fuse && step == 2) panel_wait((unsigned*)(p.ws + OFF_MISC + 2048 + 512) + pm, 16u, otid());
      e.step = step; e.gidx = (step == 0 ? 1 : step == 1 ? 2 : 0);
      gemm_tile<true>(a, w, 2048, brow, bcol, e);
    }
    if (fuse) panel_publish(cnt3 + pm, otid());
  }
}
DEV void p5_rowpair(const Params& p, const int row0, const int lane) {
  const bf16_t* y = (const bf16_t*)(p.ws + OFF_Y);
  const float* part = (const float*)(p.ws + OFF_PART);
  float ss0 = (lane < 32) ? part[(size_t)lane * NTOK + row0] : 0.f;
  float ss1 = (lane < 32) ? part[(size_t)lane * NTOK + row0 + 1] : 0.f;
  u32x2 yv[2][8]; f32x4 xv[2][8];
#pragma unroll
  for (int r = 0; r < 2; ++r)
#pragma unroll
    for (int i = 0; i < 8; ++i) {
      const size_t idx = (size_t)(row0 + r) * DM + 4 * (lane + 64 * i);
      yv[r][i] = *(const u32x2*)(y + idx); xv[r][i] = *(const f32x4*)(p.x + idx);
    }
  ss0 = wave_sum(ss0); ss1 = wave_sum(ss1);
  const float rs[2] = {rsqrtf(ss0 * (1.f / DM) + 1e-6f), rsqrtf(ss1 * (1.f / DM) + 1e-6f)};
#pragma unroll
  for (int i = 0; i < 8; ++i) {
    const f32x4 g = *(const f32x4*)(p.g_post + 4 * (lane + 64 * i));
#pragma unroll
    for (int r = 0; r < 2; ++r) {
      const size_t idx = (size_t)(row0 + r) * DM + 4 * (lane + 64 * i);
      *(f32x4*)(p.out + idx) = xv[r][i] + unpk4(yv[r][i]) * rs[r] * g;
    }
  }
}
DEV void phase4(const Params& p, const bool fuse) {
  EpiOut e; e.y = (bf16_t*)(p.ws + OFF_Y); e.part = (float*)(p.ws + OFF_PART);
  unsigned* cnt = (unsigned*)(p.ws + OFF_MISC + 2048);
  unsigned* cnt3 = (unsigned*)(p.ws + OFF_MISC + 2048 + 256);
  for (int L = blockIdx.x; L < 256; L += gridDim.x) {
    const int xcd = L & 7, off = L >> 3, wgid = xcd * 32 + off;
    const int pm = wgid >> 3, pn = wgid & 7;
    const int tidx = otid();
    if (fuse) panel_wait(cnt3 + pm, 8u, tidx);
    gemm_tile<true>((const bf16_t*)(p.ws + OFF_MBF), (const bf16_t*)(p.ws + OFF_WT_OUT), 2048, pm * 256, pn * 256, e);
    if (fuse) {
      panel_publish(cnt + pm, tidx);
      panel_wait(cnt + pm, 8u, tidx);
      const int wave = tidx >> 6, lane = tidx & 63;
      const int rbase = pm * 256 + pn * 32 + wave * 4;
      p5_rowpair(p, rbase, lane);
      p5_rowpair(p, rbase + 2, lane);
    }
  }
}
DEV void phase5(const Params& p) {
  const int tidx = otid();
  const int lane = tidx & 63;
  const int gw = blockIdx.x * 8 + (tidx >> 6), nw = gridDim.x * 8;
  for (int row0 = gw * 2; row0 < NTOK; row0 += nw * 2) p5_rowpair(p, row0, lane);
}

__global__ void __launch_bounds__(512) hybrid_layer_megakernel(Params p, int ph_lo, int ph_hi) {
  if (ph_hi == 6 && gridDim.x >= 256) ph_hi = 2;
  for (int ph = ph_lo; ph <= ph_hi; ++ph) {
    for (int rep = 0; rep < ((ph == PROBE_DUP) ? 2 : 1); ++rep) {
      if (rep) cg::this_grid().sync();
      switch (ph) {
        case 0: phase0(p); break;
        case 1: phase1(p, -1); break;
        case 2: phase2(p, rep); if (gridDim.x >= 256) { phase25(p, true); phase3(p, true); phase4(p, true); } break;
        case 3: if (gridDim.x < 256) phase25(p, false); break;
        case 4: if (gridDim.x < 256) phase3(p, false); break;
        case 5: if (gridDim.x < 256) phase4(p, false); break;
        default: if (gridDim.x < 256) phase5(p); break;
      }
    }
    if (ph < ph_hi) { cg::this_grid().sync(); }
  }
}

extern "C" void kernel_launch(void* const* d_in, const int* in_sizes, int n_in, void* d_out, int out_size, void* d_ws, size_t ws_size,
                              hipStream_t stream) {
  constexpr size_t kDynLds = 131072 + 4096 + 16384;
  static int grid_blocks = 0;
  if (!grid_blocks) {
    hipFuncSetAttribute((const void*)hybrid_layer_megakernel, hipFuncAttributeMaxDynamicSharedMemorySize, (int)kDynLds);
    int dev = 0, cus = 0, per_cu = 0;
    hipGetDevice(&dev);
    hipDeviceGetAttribute(&cus, hipDeviceAttributeMultiprocessorCount, dev);
    hipOccupancyMaxActiveBlocksPerMultiprocessor(&per_cu, hybrid_layer_megakernel, 512, kDynLds);
    if (per_cu < 1) per_cu = 1;
    if (per_cu > 1) per_cu = 1;
    grid_blocks = cus * per_cu;
  }
  Params p{};
  p.x = (const float*)d_in[0]; p.mem = (const float*)d_in[1]; p.g_pre = (const float*)d_in[2]; p.g_post = (const float*)d_in[3];
  p.g_mem = (const float*)d_in[4]; p.w_in = (const float*)d_in[5]; p.a_w2 = (const float*)d_in[6]; p.a_b = (const float*)d_in[7];
  p.g_head = (const float*)d_in[8]; p.w_mkv = (const float*)d_in[9]; p.w_pg = (const float*)d_in[10]; p.w_ps = (const float*)d_in[11];
  p.w_pm = (const float*)d_in[12]; p.w_out = (const float*)d_in[13];
  p.out = (float*)d_out; p.ws = (char*)d_ws;
  hipMemsetAsync((char*)d_ws + OFF_MISC, 0, 4096, stream);
#if MK_MULTI
  for (int ph = 0; ph <= 6; ++ph) hipLaunchKernelGGL(hybrid_layer_megakernel, dim3(grid_blocks), dim3(512), kDynLds, stream, p, ph, ph);
#else
  int lo = 0, hi = 6;
  void* args[] = {&p, &lo, &hi};
  hipError_t e = hipLaunchCooperativeKernel((const void*)hybrid_layer_megakernel, dim3(grid_blocks), dim3(512), args, kDynLds, stream);
  if (e != hipSuccess) fprintf(stderr, "cooperative launch failed: %s (grid %d)\n", hipGetErrorString(e), grid_blocks);
#endif
}
```

```cpp
#include <hip/hip_runtime.h>
#include <hip/hip_cooperative_groups.h>
#include <cstdio>
namespace cg = cooperative_groups;

#ifndef PROBE_DUP
#define PROBE_DUP -1
#endif
#ifndef PROBE_PART
#define PROBE_PART 7
#endif
#ifndef MK_MULTI
#define MK_MULTI 0
#endif

typedef unsigned short bf16_t;
typedef short bf16x8 __attribute__((ext_vector_type(8)));
typedef float f32x2 __attribute__((ext_vector_type(2)));
typedef float f32x4 __attribute__((ext_vector_type(4)));
typedef float f32x16 __attribute__((ext_vector_type(16)));
typedef unsigned u32x2 __attribute__((ext_vector_type(2)));
typedef unsigned u32x4 __attribute__((ext_vector_type(4)));
typedef __bf16 bf16x2_t __attribute__((ext_vector_type(2)));
#define DEV __device__ __forceinline__

constexpr int NTOK = 8192, DM = 2048, NPROJ = 22528;
constexpr size_t MiB = 1048576;
constexpr size_t OFF_WT_IN = 0, OFF_WT_MKV = 88 * MiB, OFF_WT_PG = 104 * MiB, OFF_WT_PS = 112 * MiB, OFF_WT_PM = 120 * MiB, OFF_WT_OUT = 128 * MiB,
                 OFF_H = 136 * MiB, OFF_MEMH = 168 * MiB, OFF_B = 172 * MiB, OFF_EB = 204 * MiB, OFF_MISC = 206 * MiB,
                 OFF_QP = 208 * MiB, OFF_KDP = 224 * MiB, OFF_KET = 240 * MiB, OFF_GVT = 256 * MiB, OFF_SGG = 288 * MiB, OFF_SQ = 320 * MiB,
                 OFF_SK = 352 * MiB, OFF_SVT = 384 * MiB, OFF_SSG = 416 * MiB, OFF_MQ = 448 * MiB, OFF_GATES = 480 * MiB, OFF_MK = 576 * MiB,
                 OFF_MVT = 580 * MiB;
constexpr size_t OFF_OP0 = OFF_WT_IN, OFF_OP1 = 584 * MiB, OFF_OB = OFF_H, OFF_OM = OFF_B, OFF_OA = 32 * MiB, OFF_MERGED = 584 * MiB, OFF_MBF = 616 * MiB, OFF_Y = 648 * MiB;
constexpr size_t OFF_PART = OFF_MISC + 4096;

struct Params {
  const float *x, *mem, *g_pre, *g_post, *g_mem, *w_in, *a_w2, *a_b, *g_head, *w_mkv, *w_pg, *w_ps, *w_pm, *w_out;
  float* out; char* ws;
};

extern __shared__ __attribute__((aligned(16))) char smem[];

DEV unsigned pk_bf16(float a, float b) { f32x2 v = {a, b}; bf16x2_t r = __builtin_convertvector(v, bf16x2_t); return __builtin_bit_cast(unsigned, r); }
DEV float bf_lo(unsigned u) { return __uint_as_float(u << 16); }
DEV float bf_hi(unsigned u) { return __uint_as_float(u & 0xffff0000u); }
DEV float wave_sum(float v) { for (int o = 32; o; o >>= 1) v += __shfl_xor(v, o); return v; }
DEV bf16x8 ld16(const bf16_t* p) { return *(const bf16x8*)p; }
DEV f32x16 mfma32(bf16x8 a, bf16x8 b, f32x16 c) { return __builtin_amdgcn_mfma_f32_32x32x16_bf16(a, b, c, 0, 0, 0); }
template <int S> DEV bf16x8 cvt8(const f32x16& v) {
  u32x4 p = {pk_bf16(v[8 * S], v[8 * S + 1]), pk_bf16(v[8 * S + 2], v[8 * S + 3]), pk_bf16(v[8 * S + 4], v[8 * S + 5]), pk_bf16(v[8 * S + 6], v[8 * S + 7])};
  return __builtin_bit_cast(bf16x8, p);
}
DEV u32x2 pk4(f32x4 v) { u32x2 r = {pk_bf16(v[0], v[1]), pk_bf16(v[2], v[3])}; return r; }
DEV f32x4 unpk4(u32x2 u) { f32x4 r = {bf_lo(u[0]), bf_hi(u[0]), bf_lo(u[1]), bf_hi(u[1])}; return r; }
DEV int sig4(int x) { return ((x & 1) << 1) | (x >> 1); }
DEV int sig16(int p) { return 8 * ((p >> 2) & 1) + 4 * (p >> 3) + (p & 3); }
DEV int otid() { int t = threadIdx.x; asm volatile("" : "+v"(t)); return t; }
DEV float fsigmoid(float x) { return 1.f / (1.f + __expf(-x)); }
DEV float logsigmoid(float x) { return fminf(x, 0.f) - __logf(1.f + __expf(-fabsf(x))); }

constexpr int BM = 256, BK = 64, HALF = 128, HT = HALF * BK;
DEV int lds_byte(int r, int c) { int st = (r >> 4) * 2 + (c >> 5), rr = r & 15, cc = c & 31, ob = rr * 64 + cc * 2; return st * 1024 + (ob ^ (((ob >> 9) & 1) << 5)); }
DEV void stage_rc(int b, int& R, int& C) { int st = b / 1024, sb = b % 1024, swz = sb ^ (((sb >> 9) & 1) << 5); R = (st >> 1) * 16 + swz / 64; C = (st & 1) * 32 + (swz % 64) / 2; }

template <bool SWAP, class Epi>
DEV void gemm_tile(const bf16_t* __restrict__ A, const bf16_t* __restrict__ Bt, const int K, const int brow, const int bcol, const Epi& epi) {
  bf16_t* shm = (bf16_t*)smem;
#define SA(b, h) (shm + ((b) * 2 + (h)) * HT)
#define SB(b, h) (shm + (4 + (b) * 2 + (h)) * HT)
#define STAGE(P, BASE, br, kt) do { const char* _gb = (const char*)(BASE) + (((long)(br) * K + (long)(kt) * BK) << 1); \
    __builtin_amdgcn_global_load_lds((const unsigned*)(_gb + so0), (unsigned*)((char*)(P) + tb), 16, 0, 0); \
    __builtin_amdgcn_global_load_lds((const unsigned*)(_gb + so1), (unsigned*)((char*)(P) + tb + 8192), 16, 0, 0); } while (0)
#define LDA(dst, b, h) for (int m = 0; m < 4; ++m) for (int k = 0; k < 2; ++k) \
    dst[m][k] = *reinterpret_cast<const bf16x8*>((char*)SA(b, h) + a_rd + m * 2048 + k * 1024)
#define LDB(dst, b, h) for (int n = 0; n < 2; ++n) for (int k = 0; k < 2; ++k) \
    dst[n][k] = *reinterpret_cast<const bf16x8*>((char*)SB(b, h) + b_rd + n * 2048 + k * 1024)
#define MMA(ai, bj, At_, Bt_) do { __builtin_amdgcn_s_setprio(1); \
    for (int m = 0; m < 4; ++m) for (int n = 0; n < 2; ++n) for (int k = 0; k < 2; ++k) \
      acc[ai][bj][m][n] = SWAP ? __builtin_amdgcn_mfma_f32_16x16x32_bf16(Bt_[n][k], At_[m][k], acc[ai][bj][m][n], 0, 0, 0) \
                               : __builtin_amdgcn_mfma_f32_16x16x32_bf16(At_[m][k], Bt_[n][k], acc[ai][bj][m][n], 0, 0, 0); \
    __builtin_amdgcn_s_setprio(0); } while (0)
#define WAIT_V(n) asm volatile("s_waitcnt vmcnt(" #n ")" ::: "memory")
#define WAIT_L(n) asm volatile("s_waitcnt lgkmcnt(" #n ")" ::: "memory")
#define BAR __builtin_amdgcn_s_barrier()
#define SCHED __builtin_amdgcn_sched_barrier(0)
  const int tidx = otid();
  const int wid = tidx >> 6, lane = tidx & 63, wr = wid >> 2, wc = wid & 3, fr = lane & 15, fq = lane >> 4;
  f32x4 acc[2][2][4][2] = {};
  bf16x8 At[4][2], B0[2][2], B1[2][2];
  const int nt = K / BK;
  const int tb = tidx * 16;
  unsigned so0, so1;
  { int r_, c_; stage_rc(tb, r_, c_); so0 = (unsigned)(r_ * K + c_) * 2u; stage_rc(tb + 8192, r_, c_); so1 = (unsigned)(r_ * K + c_) * 2u; }
  const int tb16 = (fr * 64 + fq * 16) ^ ((fr >> 3) << 5);
  const int a_rd = wr * 8192 + tb16, b_rd = wc * 4096 + tb16;
  WAIT_V(0);
  __syncthreads();
  STAGE(SB(0, 0), Bt, bcol, 0); STAGE(SA(0, 0), A, brow, 0);
  STAGE(SB(0, 1), Bt, bcol + HALF, 0); STAGE(SA(0, 1), A, brow + HALF, 0);
  if (wr == 1) BAR;
  WAIT_V(4); BAR;
  STAGE(SB(1, 0), Bt, bcol, 1); STAGE(SA(1, 0), A, brow, 1); STAGE(SB(1, 1), Bt, bcol + HALF, 1);
  WAIT_V(6); BAR;
#pragma unroll 1
  for (int t = 0; t < nt - 2; t += 2) {
    LDB(B0, 0, 0); SCHED; LDA(At, 0, 0); STAGE(SA(1, 1), A, brow + HALF, t + 1);
    WAIT_L(8); BAR; WAIT_L(0); MMA(0, 0, At, B0); BAR; SCHED;
    LDB(B1, 0, 1); STAGE(SB(0, 0), Bt, bcol, t + 2);
    BAR; WAIT_L(0); MMA(0, 1, At, B1); BAR;
    LDA(At, 0, 1); STAGE(SA(0, 0), A, brow, t + 2);
    BAR; WAIT_L(0); MMA(1, 0, At, B0); BAR; SCHED;
    STAGE(SB(0, 1), Bt, bcol + HALF, t + 2);
    WAIT_V(6); BAR; MMA(1, 1, At, B1); BAR;
    LDB(B0, 1, 0); SCHED; LDA(At, 1, 0); STAGE(SA(0, 1), A, brow + HALF, t + 2);
    WAIT_L(8); BAR; WAIT_L(0); MMA(0, 0, At, B0); BAR; SCHED;
    LDB(B1, 1, 1); STAGE(SB(1, 0), Bt, bcol, t + 3);
    BAR; WAIT_L(0); MMA(0, 1, At, B1); BAR;
    LDA(At, 1, 1); STAGE(SA(1, 0), A, brow, t + 3);
    BAR; WAIT_L(0); MMA(1, 0, At, B0); BAR; SCHED;
    STAGE(SB(1, 1), Bt, bcol + HALF, t + 3);
    WAIT_V(6); BAR; MMA(1, 1, At, B1); BAR;
  }
  { LDB(B0, 0, 0); LDA(At, 0, 0); STAGE(SA(1, 1), A, brow + HALF, nt - 1);
    BAR; WAIT_L(0); MMA(0, 0, At, B0); BAR;
    LDB(B1, 0, 1); BAR; WAIT_L(0); MMA(0, 1, At, B1); BAR;
    LDA(At, 0, 1); WAIT_V(4); BAR; WAIT_L(0); MMA(1, 0, At, B0); MMA(1, 1, At, B1); BAR; }
  { LDB(B0, 1, 0); LDA(At, 1, 0); WAIT_V(2); BAR; WAIT_L(0); MMA(0, 0, At, B0); BAR;
    LDB(B1, 1, 1); WAIT_V(0); BAR; WAIT_L(0); MMA(0, 1, At, B1); BAR;
    LDA(At, 1, 1); BAR; WAIT_L(0); MMA(1, 0, At, B0); MMA(1, 1, At, B1); BAR; }
  if (wr == 0) BAR;
  {
    int tx = tidx, br2 = brow, bc2 = bcol;
    asm volatile("" : "+v"(tx), "+s"(br2), "+s"(bc2));
    const int wid2 = tx >> 6, lane2 = tx & 63;
    epi(acc, br2, bc2, wid2 >> 2, wid2 & 3, lane2 & 15, lane2 >> 4);
  }
#undef SA
#undef SB
}

DEV void tile_rows_out(bf16_t* __restrict__ out0, const size_t ld, const int tid) {
#pragma unroll
  for (int i = 0; i < 16; ++i) {
    const int id = i * 512 + tid, r = id >> 5, pos = id & 31, c = pos ^ (r & 31);
    *(u32x4*)(out0 + (size_t)r * ld + 8 * c) = *(const u32x4*)(smem + r * 512 + pos * 16);
  }
}
DEV void tile_rows_in(const bf16_t* __restrict__ src0, const size_t ld, const int tid) {
#pragma unroll 1
  for (int io = 0; io < 4; ++io) {
    u32x4 v[4];
#pragma unroll
    for (int ii = 0; ii < 4; ++ii) {
      const int id = (io * 4 + ii) * 512 + tid, r = id >> 5, pos = id & 31, c = pos ^ (r & 31);
      v[ii] = *(const u32x4*)(src0 + (size_t)r * ld + 8 * c);
    }
#pragma unroll
    for (int ii = 0; ii < 4; ++ii) {
      const int id = (io * 4 + ii) * 512 + tid, r = id >> 5, pos = id & 31;
      *(u32x4*)(smem + r * 512 + pos * 16) = v[ii];
    }
  }
}
DEV u32x2 tile_get4(const int r, const int col4) { return *(const u32x2*)(smem + r * 512 + ((((col4 >> 3)) ^ (r & 31)) * 16) + ((col4 & 4) << 1)); }
DEV void tile_put4(const int r, const int col4, const u32x2 v) {
  *(u32x2*)(smem + r * 512 + ((((col4 >> 3)) ^ (r & 31)) * 16) + ((col4 & 4) << 1)) = v;
}
struct EpiP1 {
  int mode;
  bf16_t* out; int ld; int segstart; float scale; const float* bmat; bf16_t* keT;
  DEV void operator()(f32x4 (&acc)[2][2][4][2], int brow, int bcol, int wr, int wc, int fr, int fq) const {
#pragma unroll
    for (int ai = 0; ai < 2; ++ai)
#pragma unroll
      for (int m = 0; m < 4; ++m) {
        const int rl = ai * 128 + wr * 64 + m * 16 + fr, tok = brow + rl;
#pragma unroll
        for (int bj = 0; bj < 2; ++bj)
#pragma unroll
          for (int n = 0; n < 2; ++n) {
            const int cl = bj * 128 + wc * 32 + n * 16 + fq * 4, lc = bcol - segstart + cl;
            f32x4 v = acc[ai][bj][m][n];
            if (mode == 0) {
              tile_put4(rl, cl, pk4(v * scale));
            } else if (mode == 1) {
              for (int j = 0; j < 4; ++j) v[j] = v[j] * fsigmoid(v[j]);
              tile_put4(rl, cl, pk4(v));
            } else if (mode == 2) {
              for (int j = 0; j < 4; ++j) v[j] = fsigmoid(v[j]);
              tile_put4(rl, cl, pk4(v));
            } else {
              const f32x4 b4 = *(const f32x4*)(bmat + (size_t)tok * 1024 + lc);
              const int pcl = (cl & ~15) + 4 * sig4((cl >> 2) & 3);
              if (mode == 3) {
                for (int j = 0; j < 4; ++j) v[j] = v[j] * scale * __expf(b4[j]);
                tile_put4(rl, pcl, pk4(v));
              } else {
                const f32x4 bl = *(const f32x4*)(bmat + (size_t)(tok | 63) * 1024 + lc);
                f32x4 kd, ke;
                for (int j = 0; j < 4; ++j) { kd[j] = v[j] * __expf(-b4[j]); ke[j] = v[j] * __expf(bl[j] - b4[j]); }
                tile_put4(rl, pcl, pk4(kd));
                (void)ke;
              }
            }
          }
      }
    __syncthreads();
    tile_rows_out(out + (size_t)brow * ld + (bcol - segstart), (size_t)ld, (wr * 4 + wc) * 64 + fq * 16 + fr);
    if (mode == 4) {
      __syncthreads();
#pragma unroll
      for (int ai = 0; ai < 2; ++ai)
#pragma unroll
        for (int m = 0; m < 4; ++m) {
          const int rl = ai * 128 + wr * 64 + m * 16 + fr, tok = brow + rl;
          const int tposl = (rl & ~15) + sig16(rl & 15);
#pragma unroll
          for (int bj = 0; bj < 2; ++bj)
#pragma unroll
            for (int n = 0; n < 2; ++n) {
              const int cl = bj * 128 + wc * 32 + n * 16 + fq * 4, lc = bcol - segstart + cl;
              const f32x4 v = acc[ai][bj][m][n];
              const f32x4 b4 = *(const f32x4*)(bmat + (size_t)tok * 1024 + lc);
              const f32x4 bl = *(const f32x4*)(bmat + (size_t)(tok | 63) * 1024 + lc);
              const u32x2 kk = pk4((f32x4){v[0] * __expf(bl[0] - b4[0]), v[1] * __expf(bl[1] - b4[1]), v[2] * __expf(bl[2] - b4[2]), v[3] * __expf(bl[3] - b4[3])});
#pragma unroll
              for (int j = 0; j < 4; ++j) {
                const int row = cl + j;
                const unsigned short val = (unsigned short)((j & 1) ? (kk[j >> 1] >> 16) : (kk[j >> 1] & 0xffff));
                *(unsigned short*)(smem + row * 512 + (((tposl >> 3) ^ (row & 31)) * 16) + (tposl & 7) * 2) = val;
              }
            }
        }
      __syncthreads();
      const int bt = brow >> 11, tl0 = brow & 2047, hd = (bcol - segstart) >> 8;
      tile_rows_out(keT + ((size_t)((bt * 4 + hd) * 256)) * 2048 + tl0, 2048, (wr * 4 + wc) * 64 + fq * 16 + fr);
    }
  }
};
struct EpiVT {
  bf16_t* out; int nch; int tshift; int segstart;
  DEV void operator()(f32x4 (&acc)[2][2][4][2], int brow, int bcol, int wr, int wc, int fr, int fq) const {
    const int T = 1 << tshift;
#pragma unroll
    for (int ai = 0; ai < 2; ++ai)
#pragma unroll
      for (int m = 0; m < 4; ++m) {
        const int tposl = ai * 128 + wr * 64 + m * 16 + 4 * sig4(fq);
#pragma unroll
        for (int bj = 0; bj < 2; ++bj)
#pragma unroll
          for (int n = 0; n < 2; ++n) tile_put4(bj * 128 + wc * 32 + n * 16 + fr, tposl, pk4(acc[ai][bj][m][n]));
      }
    __syncthreads();
    const int bt = brow >> tshift, tl0 = brow & (T - 1);
    tile_rows_out(out + ((size_t)(bt * nch + (bcol - segstart)) << tshift) + tl0, (size_t)T, (wr * 4 + wc) * 64 + fq * 16 + fr);
  }
};
struct EpiMerge {
  int step; int gidx; const bf16_t* gates; float* mg; bf16_t* mbf;
  DEV void operator()(f32x4 (&acc)[2][2][4][2], int brow, int bcol, int wr, int wc, int fr, int fq) const {
    const int tid = (wr * 4 + wc) * 64 + fq * 16 + fr;
    u32x2* sp = (u32x2*)mg + ((size_t)((brow >> 8) * 8 + (bcol >> 8)) * 32) * 512 + tid;
    tile_rows_in(gates + (size_t)brow * 6144 + gidx * 2048 + bcol, 6144, tid);
    __syncthreads();
#pragma unroll
    for (int ai = 0; ai < 2; ++ai)
#pragma unroll
      for (int m = 0; m < 4; ++m) {
        const int rl = ai * 128 + wr * 64 + m * 16 + fr, tok = brow + rl;
#pragma unroll
        for (int bj = 0; bj < 2; ++bj)
#pragma unroll
          for (int n = 0; n < 2; ++n) {
            const int cl = bj * 128 + wc * 32 + n * 16 + fq * 4, col = bcol + cl;
            const int f = ((ai * 4 + m) * 2 + bj) * 2 + n;
            const f32x4 g = unpk4(tile_get4(rl, cl));
            f32x4 v = acc[ai][bj][m][n] * g;
            if (step == 0) sp[(size_t)f * 512] = pk4(v);
            else if (step == 1) sp[(size_t)f * 512] = pk4(unpk4(sp[(size_t)f * 512]) + v);
            else tile_put4(rl, cl, pk4(unpk4(sp[(size_t)f * 512]) + v));
          }
      }
    if (step == 2) {
      __syncthreads();
      tile_rows_out(mbf + (size_t)brow * 2048 + bcol, 2048, tid);
    }
  }
};
struct EpiOut {
  bf16_t* y; float* part;
  DEV void operator()(f32x4 (&acc)[2][2][4][2], int brow, int bcol, int wr, int wc, int fr, int fq) const {
    const int tid = (wr * 4 + wc) * 64 + fq * 16 + fr;
#pragma unroll
    for (int ai = 0; ai < 2; ++ai)
#pragma unroll
      for (int m = 0; m < 4; ++m) {
        const int rl = ai * 128 + wr * 64 + m * 16 + fr, tok = brow + rl;
        float ss = 0.f;
#pragma unroll
        for (int bj = 0; bj < 2; ++bj)
#pragma unroll
          for (int n = 0; n < 2; ++n) {
            const int cl = bj * 128 + wc * 32 + n * 16 + fq * 4;
            const f32x4 v = acc[ai][bj][m][n];
            tile_put4(rl, cl, pk4(v));
            ss += v[0] * v[0] + v[1] * v[1] + v[2] * v[2] + v[3] * v[3];
          }
        ss += __shfl_xor(ss, 16); ss += __shfl_xor(ss, 32);
        if (fq == 0) part[(size_t)((bcol >> 8) * 4 + wc) * NTOK + tok] = ss;
      }
    __syncthreads();
    tile_rows_out(y + (size_t)brow * 2048 + bcol, 2048, tid);
  }
};

DEV void norm_rows64(const float* __restrict__ src, const float* __restrict__ g, bf16_t* __restrict__ dst, int r0) {
  const int tidx = otid();
  const int wave = tidx >> 6, lane = tidx & 63;
  for (int rr = 0; rr < 8; rr += 2) {
    const int row = r0 + wave * 8 + rr;
    const f32x4* xr = (const f32x4*)(src + (size_t)row * DM);
    f32x4 v[2][8]; float ss0 = 0.f, ss1 = 0.f;
#pragma unroll
    for (int i = 0; i < 8; ++i) { v[0][i] = xr[lane + 64 * i]; v[1][i] = xr[512 + lane + 64 * i]; }
#pragma unroll
    for (int i = 0; i < 8; ++i) {
      ss0 += v[0][i][0] * v[0][i][0] + v[0][i][1] * v[0][i][1] + v[0][i][2] * v[0][i][2] + v[0][i][3] * v[0][i][3];
      ss1 += v[1][i][0] * v[1][i][0] + v[1][i][1] * v[1][i][1] + v[1][i][2] * v[1][i][2] + v[1][i][3] * v[1][i][3];
    }
    ss0 = wave_sum(ss0); ss1 = wave_sum(ss1);
    const float rs[2] = {rsqrtf(ss0 * (1.f / DM) + 1e-6f), rsqrtf(ss1 * (1.f / DM) + 1e-6f)};
#pragma unroll
    for (int i = 0; i < 8; ++i) {
      const f32x4 g4 = ((const f32x4*)g)[lane + 64 * i];
#pragma unroll
      for (int r = 0; r < 2; ++r) *(u32x2*)(dst + (size_t)(row + r) * DM + 4 * (lane + 64 * i)) = pk4(v[r][i] * rs[r] * g4);
    }
  }
}

DEV void p0_chunk(const Params& p, int item) {
  const int tid = otid(), wave = tid >> 6, lane = tid & 63;
  const int r0 = item * 64;
  bf16_t* h = (bf16_t*)(p.ws + OFF_H);
  norm_rows64(p.x, p.g_pre, h, r0);
  __syncthreads();
  float* gaL = (float*)smem;
  {
    const int row = lane & 15, kg = lane >> 4, tg = wave & 3, kh = wave >> 2;
    const bf16_t* ap = h + (size_t)(r0 + tg * 16 + row) * DM + 8 * kg + 1024 * kh;
    const float* wp = p.w_in + (size_t)(8 * kg + 1024 * kh) * 22544 + 6144 + row;
    f32x4 acc = {0.f, 0.f, 0.f, 0.f};
#pragma unroll 8
    for (int s = 0; s < 32; ++s) {
      const bf16x8 a = ld16(ap + 32 * s);
      float w[8];
#pragma unroll
      for (int e = 0; e < 8; ++e) w[e] = wp[(size_t)(32 * s + e) * 22544];
      u32x4 bw = {pk_bf16(w[0], w[1]), pk_bf16(w[2], w[3]), pk_bf16(w[4], w[5]), pk_bf16(w[6], w[7])};
      acc = __builtin_amdgcn_mfma_f32_16x16x32_bf16(a, __builtin_bit_cast(bf16x8, bw), acc, 0, 0, 0);
    }
#pragma unroll
    for (int j = 0; j < 4; ++j) gaL[kh * 1024 + (tg * 16 + kg * 4 + j) * 16 + row] = acc[j];
  }
  __syncthreads();
  float* bmat = (float*)(p.ws + OFF_B);
  float* eb = (float*)(p.ws + OFF_EB);
  float w2c[2][16], bias[2], run[2] = {0.f, 0.f};
#pragma unroll
  for (int k = 0; k < 2; ++k) {
    const int c = tid + 512 * k;
    bias[k] = p.a_b[c];
#pragma unroll
    for (int r = 0; r < 16; ++r) w2c[k][r] = p.a_w2[r * 1024 + c];
  }
  for (int tok = 0; tok < 64; ++tok) {
    float g[16];
#pragma unroll
    for (int q = 0; q < 4; ++q) { const f32x4 t4 = *(const f32x4*)(gaL + tok * 16 + 4 * q) + *(const f32x4*)(gaL + 1024 + tok * 16 + 4 * q); g[4 * q] = t4[0]; g[4 * q + 1] = t4[1]; g[4 * q + 2] = t4[2]; g[4 * q + 3] = t4[3]; }
#pragma unroll
    for (int k = 0; k < 2; ++k) {
      float xv = bias[k];
#pragma unroll
      for (int r = 0; r < 16; ++r) xv += g[r] * w2c[k][r];
      run[k] += logsigmoid(xv) * (1.f / 16.f);
      bmat[(size_t)(r0 + tok) * 1024 + tid + 512 * k] = run[k];
    }
  }
#pragma unroll
  for (int k = 0; k < 2; ++k) eb[(size_t)item * 1024 + tid + 512 * k] = __expf(run[k]);
  __syncthreads();
}

DEV void p0_transpose8(const Params& p, int nt2, int kq) {
  const float* src; int ld, scol; bf16_t* dst;
  const int nt = nt2 * 2;
  if (nt < 352) { const int c = nt * 64; src = p.w_in; ld = 22544; scol = c + (c >= 6144 ? 16 : 0); dst = (bf16_t*)(p.ws + OFF_WT_IN) + (size_t)c * 2048; }
  else if (nt < 416) { const int c = (nt - 352) * 64; src = p.w_mkv; ld = 4096; scol = c; dst = (bf16_t*)(p.ws + OFF_WT_MKV) + (size_t)c * 2048; }
  else if (nt < 448) { const int c = (nt - 416) * 64; src = p.w_pg; ld = 2048; scol = c; dst = (bf16_t*)(p.ws + OFF_WT_PG) + (size_t)c * 2048; }
  else if (nt < 480) { const int c = (nt - 448) * 64; src = p.w_ps; ld = 2048; scol = c; dst = (bf16_t*)(p.ws + OFF_WT_PS) + (size_t)c * 2048; }
  else if (nt < 512) { const int c = (nt - 480) * 64; src = p.w_pm; ld = 2048; scol = c; dst = (bf16_t*)(p.ws + OFF_WT_PM) + (size_t)c * 2048; }
  else { const int c = (nt - 512) * 64; src = p.w_out; ld = 2048; scol = c; dst = (bf16_t*)(p.ws + OFF_WT_OUT) + (size_t)c * 2048; }
  const int t = otid();
  const int k0 = kq * 256;
  unsigned* T32 = (unsigned*)smem;
  {
    const int r2 = t >> 5, c4 = t & 31;
    const float* sp = src + (size_t)(k0 + 2 * r2) * ld + scol + 4 * c4;
    f32x4 v0[8], v1[8];
#pragma unroll
    for (int kk = 0; kk < 8; ++kk) {
      v0[kk] = __builtin_nontemporal_load((const f32x4*)(sp + (size_t)(kk * 32) * ld)); v1[kk] = __builtin_nontemporal_load((const f32x4*)(sp + (size_t)(kk * 32 + 1) * ld)); }
#pragma unroll
    for (int kk = 0; kk < 8; ++kk)
#pragma unroll
      for (int j = 0; j < 4; ++j) T32[(kk * 128 + 4 * c4 + j) * 17 + r2] = pk_bf16(v0[kk][j], v1[kk][j]);
  }
  __syncthreads();
  {
    const int n = t >> 2, g = t & 3;
#pragma unroll
    for (int i = 0; i < 8; ++i) {
      const int ch = g + 4 * i, kk = ch >> 2, w4 = (ch & 3) * 4;
      const unsigned* tp = T32 + (kk * 128 + n) * 17 + w4;
      const u32x4 w = {tp[0], tp[1], tp[2], tp[3]};
      *(u32x4*)(dst + (size_t)n * 2048 + k0 + 8 * ch) = w;
    }
  }
  __syncthreads();
}

DEV void phase0(const Params& p) {
  const int tidx = otid();
  unsigned* ctr = (unsigned*)(p.ws + OFF_MISC + 512);
  volatile int* slot = (volatile int*)(smem + 131072 + 2048);
  const int total = 128 + 16 + 272 * 8;
  bool first = true;
  while (true) {
    __syncthreads();
    if (tidx == 0) *slot = first ? (int)blockIdx.x : (int)(gridDim.x + atomicAdd(ctr, 1u));
    first = false;
    __syncthreads();
    const int it = __builtin_amdgcn_readfirstlane(*slot);
    if (it >= total) break;
    if (it < 128) p0_chunk(p, it);
    else if (it < 144) { norm_rows64(p.mem, p.g_mem, (bf16_t*)(p.ws + OFF_MEMH), (it - 128) * 64); }
    else { const int tt = it - 144; p0_transpose8(p, tt >> 3, tt & 7); }
  }
}

#define MKV_IN_P2 1
DEV void phase1(const Params& p, const int base_item) {
  const int nwg = MKV_IN_P2 ? 2816 : 2816 + 64;
  const int Lbeg = base_item >= 0 ? base_item : (int)blockIdx.x, Lend = base_item >= 0 ? base_item + 1 : nwg;
#pragma unroll 1
  for (int L = Lbeg; L < Lend; L += gridDim.x) {
    const bf16_t* a; const bf16_t* w; int brow, bcol; bool vt;
    EpiVT ev; EpiP1 e;
    e.bmat = (const float*)(p.ws + OFF_B); e.keT = (bf16_t*)(p.ws + OFF_KET); e.ld = 2048; e.scale = 1.f; e.mode = 0; e.out = nullptr; e.segstart = 0;
    ev.out = nullptr; ev.nch = 2048; ev.tshift = 11; ev.segstart = 0;
    if (L < 2816) {
      const int xcd = L & 7, off = L >> 3, wgid = xcd * 352 + off;
      const int nig = 8 * 88, gid = wgid / nig, pm = gid * 8 + (wgid % nig) % 8, pn = (wgid % nig) / 8;
      brow = pm * 256; bcol = pn * 256;
      a = (const bf16_t*)(p.ws + OFF_H); w = (const bf16_t*)(p.ws + OFF_WT_IN);
      vt = (bcol >= 2048 && bcol < 4096) || (bcol >= 10240 && bcol < 12288);
      if (vt) {
        if (bcol < 4096) { ev.out = (bf16_t*)(p.ws + OFF_GVT); ev.segstart = 2048; } else { ev.out = (bf16_t*)(p.ws + OFF_SVT); ev.segstart = 10240; }
      } else {
        if (bcol < 1024) { e.mode = 3; e.out = (bf16_t*)(p.ws + OFF_QP); e.segstart = 0; e.scale = 1.f / 16.f; e.ld = 1024; }
        else if (bcol < 2048) { e.mode = 4; e.out = (bf16_t*)(p.ws + OFF_KDP); e.segstart = 1024; e.ld = 1024; }
        else if (bcol < 6144) { e.mode = 1; e.out = (bf16_t*)(p.ws + OFF_SGG); e.segstart = 4096; }
        else if (bcol < 8192) { e.mode = 0; e.out = (bf16_t*)(p.ws + OFF_SQ); e.segstart = 6144; e.scale = 0.08838834764831845f * 1.4426950408889634f; }
        else if (bcol < 10240) { e.mode = 0; e.out = (bf16_t*)(p.ws + OFF_SK); e.segstart = 8192; }
        else if (bcol < 14336) { e.mode = 1; e.out = (bf16_t*)(p.ws + OFF_SSG); e.segstart = 12288; }
        else if (bcol < 16384) { e.mode = 0; e.out = (bf16_t*)(p.ws + OFF_MQ); e.segstart = 14336; e.scale = 0.04419417382415922f; }
        else { e.mode = 2; e.out = (bf16_t*)(p.ws + OFF_GATES); e.segstart = 16384; e.ld = 6144; }
      }
    } else {
      const int l = L - 2816, pm = l & 3, pn = l >> 2;
      brow = pm * 256; bcol = pn * 256;
      a = (const bf16_t*)(p.ws + OFF_MEMH); w = (const bf16_t*)(p.ws + OFF_WT_MKV);
      vt = bcol >= 2048;
      if (vt) { ev.out = (bf16_t*)(p.ws + OFF_MVT); ev.tshift = 8; ev.segstart = 2048; }
      else { e.mode = 0; e.out = (bf16_t*)(p.ws + OFF_MK); }
    }
    if (vt) gemm_tile<false>(a, w, 2048, brow, bcol, ev);
    else gemm_tile<true>(a, w, 2048, brow, bcol, e);
  }
}

DEV void panel_publish(unsigned* cnt, const int tidx) {
  asm volatile("s_waitcnt vmcnt(0)" ::: "memory");
  __syncthreads();
  if (tidx == 0) {
    __builtin_amdgcn_fence(__ATOMIC_RELEASE, "agent");
    asm volatile("s_waitcnt vmcnt(0)" ::: "memory");
    __hip_atomic_fetch_add(cnt, 1u, __ATOMIC_RELAXED, __HIP_MEMORY_SCOPE_AGENT);
  }
}
DEV void panel_wait(unsigned* cnt, const unsigned need, const int tidx) {
  if (tidx == 0) {
    while (__hip_atomic_load(cnt, __ATOMIC_RELAXED, __HIP_MEMORY_SCOPE_AGENT) < need) __builtin_amdgcn_s_sleep(2);
    __builtin_amdgcn_fence(__ATOMIC_ACQUIRE, "agent");
    asm volatile("s_waitcnt vmcnt(0)" ::: "memory");
  }
  __syncthreads();
}
#define GLDS16(src_, dst_) __builtin_amdgcn_global_load_lds((const unsigned*)(src_), (unsigned*)(dst_), 16, 0, 0)

DEV void gla_block(const Params& p, int g) {
  const int tidx = otid();
  const int wave = __builtin_amdgcn_readfirstlane(tidx >> 6), lane = tidx & 63, l31 = lane & 31, hh = lane >> 5;
  const int bh = g >> 2, b = bh >> 2, h = bh & 3, dkh = wave >> 2, vs = (g & 3) * 4 + (wave & 3);
  const bf16_t* Qp = (const bf16_t*)(p.ws + OFF_QP);
  const bf16_t* KeT = (const bf16_t*)(p.ws + OFF_KET);
  const bf16_t* gvT = (const bf16_t*)(p.ws + OFF_GVT);
  const float* eb = (const float*)(p.ws + OFF_EB);
  f32x16 S[4];
#pragma unroll
  for (int t = 0; t < 4; ++t) for (int gg = 0; gg < 16; ++gg) S[t][gg] = 0.f;
  const bf16_t* vrow = gvT + ((size_t)(b * 2048 + h * 512 + vs * 32 + l31)) * 2048 + 8 * hh;
  const bf16_t* qsrc; const bf16_t* ksrc;
  {
    const int rq = lane >> 5, pq = lane & 31;
    const int rk = lane >> 3, pk = lane & 7;
    qsrc = Qp + ((size_t)b * 2048 + rq) * 1024 + h * 256;
    ksrc = KeT + ((size_t)((b * 4 + h) * 256 + rk)) * 2048;
    (void)pq; (void)pk;
  }
#define GLA_DMA(c_, buf_) do { const int tok0_ = (c_) * 64; \
    _Pragma("unroll") for (int i_ = 0; i_ < 8; ++i_) { const int k_ = wave * 8 + i_; \
      if (k_ < 32) { const int r_ = 2 * k_ + (lane >> 5); \
        GLDS16(qsrc + (size_t)(tok0_ + 2 * k_) * 1024 + (((lane & 31) ^ (r_ & 31)) * 8), smem + (buf_) * 65536 + k_ * 1024 + lane * 16); } \
      else { const int kk_ = k_ - 32, r_ = 8 * kk_ + (lane >> 3); \
        GLDS16(ksrc + (size_t)(8 * kk_) * 2048 + tok0_ + (((lane & 7) ^ ((r_ >> 1) & 7)) * 8), smem + (buf_) * 65536 + 32768 + kk_ * 1024 + lane * 16); } } } while (0)
#define GLA_EB(c_, buf_) do { if (wave == 0) GLDS16(eb + (size_t)(b * 32 + (c_)) * 1024 + h * 256 + lane * 4, smem + 131072 + (buf_) * 1024 + lane * 16); } while (0)
  const int Q0 = l31 * 512 + (((16 * dkh + hh) ^ l31) * 16);
  const int K0 = 32768 + (128 * dkh + l31) * 128 + ((hh ^ ((l31 >> 1) & 7)) * 16);
  asm volatile("s_waitcnt vmcnt(0)" ::: "memory");
  __syncthreads();
  GLA_DMA(0, 0); GLA_EB(0, 0);
  bf16x8 vf[4], vfn[4];
#pragma unroll
  for (int s4 = 0; s4 < 4; ++s4) { vf[s4] = ld16(vrow + 16 * s4); vfn[s4] = vf[s4]; }
  asm volatile("s_waitcnt vmcnt(0)" ::: "memory");
  __syncthreads();
#pragma unroll 1
  for (int c = 0; c < 32; ++c) {
    const int tok0 = c * 64, buf = c & 1;
    const size_t grow = (size_t)b * 2048 + tok0;
    if (c + 1 < 32) {
      GLA_DMA(c + 1, buf ^ 1); GLA_EB(c + 1, buf ^ 1);
#pragma unroll
      for (int s4 = 0; s4 < 4; ++s4) vfn[s4] = ld16(vrow + tok0 + 64 + 16 * s4);
    }
    const char* lq = smem + buf * 65536;
    int q0v = Q0, k0v = K0;
    asm volatile("" : "+v"(q0v), "+v"(k0v));
    f32x16 o0, o1;
    for (int gg = 0; gg < 16; ++gg) { o0[gg] = 0.f; o1[gg] = 0.f; }
#pragma unroll
    for (int th = 0; th < 2; ++th) {
      bf16x8 qa[2][2], qb_[2][2];
#pragma unroll
      for (int t = 0; t < 2; ++t)
#pragma unroll
        for (int s = 0; s < 2; ++s) { qa[t][s] = *(const bf16x8*)(lq + (q0v ^ (64 * (2 * th + t) + 32 * s))); qb_[t][s] = *(const bf16x8*)(lq + (q0v ^ (64 * (2 * th + t) + 32 * s)) + 32 * 512); }
      __builtin_amdgcn_sched_barrier(0);
#pragma unroll
      for (int t = 0; t < 2; ++t) {
        const bf16x8 s0 = cvt8<0>(S[2 * th + t]), s1 = cvt8<1>(S[2 * th + t]);
        o0 = mfma32(s0, qa[t][0], o0); o1 = mfma32(s0, qb_[t][0], o1);
        o0 = mfma32(s1, qa[t][1], o0); o1 = mfma32(s1, qb_[t][1], o1);
      }
      __builtin_amdgcn_sched_barrier(0);
    }
    {
      const float* ebl = (const float*)(smem + 131072 + buf * 1024) + dkh * 128 + 4 * hh;
#pragma unroll
      for (int t = 0; t < 4; ++t)
#pragma unroll
        for (int q = 0; q < 4; ++q) { const f32x4 e4 = *(const f32x4*)(ebl + 32 * t + 8 * q); for (int j = 0; j < 4; ++j) S[t][4 * q + j] *= e4[j]; }
#pragma unroll
      for (int sh = 0; sh < 2; ++sh) {
        bf16x8 kf[4][2];
#pragma unroll
        for (int t = 0; t < 4; ++t)
#pragma unroll
          for (int s = 0; s < 2; ++s) kf[t][s] = *(const bf16x8*)(lq + (k0v ^ (32 * (2 * sh + s))) + t * 4096);
        __builtin_amdgcn_sched_barrier(0);
#pragma unroll
        for (int s = 0; s < 2; ++s)
#pragma unroll
          for (int t = 0; t < 4; ++t) S[t] = mfma32(kf[t][s], vf[2 * sh + s], S[t]);
        __builtin_amdgcn_sched_barrier(0);
      }
    }
#pragma unroll
    for (int s4 = 0; s4 < 4; ++s4) vf[s4] = vfn[s4];
    u32x2* xch = (u32x2*)(smem + 135168) + (wave & 3) * 512 + lane;
    __syncthreads();
    if (dkh == 1) {
#pragma unroll
      for (int q = 0; q < 4; ++q) {
        const f32x4 a0 = {o0[4 * q], o0[4 * q + 1], o0[4 * q + 2], o0[4 * q + 3]}, a1 = {o1[4 * q], o1[4 * q + 1], o1[4 * q + 2], o1[4 * q + 3]};
        xch[q * 64] = pk4(a0); xch[(4 + q) * 64] = pk4(a1);
      }
    }
    asm volatile("s_waitcnt vmcnt(0)" ::: "memory");
    __syncthreads();
    if (dkh == 0) {
      u32x2* o_ = (u32x2*)(p.ws + OFF_OP0) + ((((size_t)((b * 32 + c) * 4 + h) * 16 + vs) * 2) * 4) * 64 + lane;
#pragma unroll
      for (int q = 0; q < 4; ++q) {
        const f32x4 a0 = {o0[4 * q], o0[4 * q + 1], o0[4 * q + 2], o0[4 * q + 3]}, a1 = {o1[4 * q], o1[4 * q + 1], o1[4 * q + 2], o1[4 * q + 3]};
        o_[q * 64] = pk4(a0 + unpk4(xch[q * 64])); o_[(4 + q) * 64] = pk4(a1 + unpk4(xch[(4 + q) * 64]));
      }
    }
  }
  asm volatile("s_waitcnt vmcnt(0)" ::: "memory");
  __syncthreads();
#undef GLA_EB
#undef GLA_DMA
  panel_publish((unsigned*)(p.ws + OFF_MISC + 2048 + 768) + bh, tidx);
}

template <bool DIAG>
DEV void sb_tile(const char* lk, const char* lv, const int ko0, const int vo0, const bf16x8 (&qf)[8], f32x16 (&O)[4], float& accp,
                 const int l31, const int hh) {
  f32x16 z;
  for (int g = 0; g < 16; ++g) z[g] = 0.f;
  {
    bf16x8 kf[8];
#pragma unroll
    for (int s = 0; s < 8; ++s) kf[s] = *(const bf16x8*)(lk + (ko0 ^ (32 * s)));
    __builtin_amdgcn_sched_barrier(0);
#pragma unroll
    for (int s = 0; s < 8; ++s) z = mfma32(kf[s], qf[s], z);
  }
  bf16x8 vf[4][2];
#pragma unroll
  for (int d = 0; d < 4; ++d) { vf[d][0] = *(const bf16x8*)(lv + d * 4096 + vo0); vf[d][1] = *(const bf16x8*)(lv + d * 4096 + (vo0 ^ 32)); }
  __builtin_amdgcn_sched_barrier(0);
  float be[16], om[16];
#pragma unroll
  for (int g = 0; g < 16; ++g) {
    const float e = __builtin_amdgcn_exp2f(fminf(-z[g], 120.f));
    be[g] = __builtin_amdgcn_rcpf(1.f + e);
    om[g] = e * be[g];
    if (DIAG) { const int kl = (g & 3) + 8 * (g >> 2) + 4 * hh; if (kl >= l31) { be[g] = 0.f; om[g] = 1.f; } }
  }
  float gp[4], pp[4], tot[4];
#pragma unroll
  for (int q = 0; q < 4; ++q) { gp[q] = (om[4 * q] * om[4 * q + 1]) * (om[4 * q + 2] * om[4 * q + 3]); pp[q] = __shfl_xor(gp[q], 32); tot[q] = gp[q] * pp[q]; }
  float suf[4];
  suf[3] = accp; suf[2] = suf[3] * tot[3]; suf[1] = suf[2] * tot[2]; suf[0] = suf[1] * tot[1];
  accp = suf[0] * tot[0];
  f32x16 w;
#pragma unroll
  for (int q = 0; q < 4; ++q) {
    float a = suf[q] * (hh == 0 ? pp[q] : 1.f);
    w[4 * q + 3] = be[4 * q + 3] * a; a *= om[4 * q + 3];
    w[4 * q + 2] = be[4 * q + 2] * a; a *= om[4 * q + 2];
    w[4 * q + 1] = be[4 * q + 1] * a; a *= om[4 * q + 1];
    w[4 * q + 0] = be[4 * q + 0] * a;
  }
  const bf16x8 w0 = cvt8<0>(w), w1 = cvt8<1>(w);
#pragma unroll
  for (int d = 0; d < 4; ++d) { O[d] = mfma32(vf[d][0], w0, O[d]); O[d] = mfma32(vf[d][1], w1, O[d]); }
}

DEV void sb_block(const Params& p, int item) {
  const int tidx = otid();
  const int wave = __builtin_amdgcn_readfirstlane(tidx >> 6), lane = tidx & 63, l31 = lane & 31, hh = lane >> 5;
  const int qb = 7 - (item >> 6), bh = item & 63, b = bh >> 4, h = bh & 15;
  const int qt = 8 * qb + wave;
  const bf16_t* sq = (const bf16_t*)(p.ws + OFF_SQ);
  const bf16_t* sk = (const bf16_t*)(p.ws + OFF_SK);
  const bf16_t* svT = (const bf16_t*)(p.ws + OFF_SVT);
  const bf16_t* ssg = (const bf16_t*)(p.ws + OFF_SSG);
  bf16_t* ob = (bf16_t*)(p.ws + OFF_OB);
  const size_t row0 = (size_t)b * 2048;
  bf16x8 qf[8];
  {
    const bf16_t* qp = sq + (row0 + qt * 32 + l31) * 2048 + h * 128 + 8 * hh;
#pragma unroll
    for (int s = 0; s < 8; ++s) qf[s] = ld16(qp + 16 * s);
  }
  f32x16 O[4];
#pragma unroll
  for (int d = 0; d < 4; ++d) for (int g = 0; g < 16; ++g) O[d][g] = 0.f;
  float accp = 1.f;
  const bf16_t* ksrc = sk + (row0 + (lane >> 4)) * 2048 + h * 128;
  const bf16_t* vsrc = svT + ((size_t)(b * 2048 + h * 128 + (lane >> 3))) * 2048;
#define SB_DMA(j_, buf_) do { \
    _Pragma("unroll") for (int i_ = 0; i_ < 4; ++i_) { const int k_ = wave * 4 + i_; \
      if (k_ < 16) { const int r_ = 4 * k_ + (lane >> 4); \
        GLDS16(ksrc + (size_t)(64 * (j_) + 4 * k_) * 2048 + (((lane & 15) ^ (r_ & 15)) * 8), smem + (buf_) * 32768 + k_ * 1024 + lane * 16); } \
      else { const int kk_ = k_ - 16, r_ = 8 * kk_ + (lane >> 3); \
        GLDS16(vsrc + (size_t)(8 * kk_) * 2048 + 64 * (j_) + (((lane & 7) ^ ((r_ >> 1) & 7)) * 8), smem + (buf_) * 32768 + 16384 + kk_ * 1024 + lane * 16); } } } while (0)
  const int KO0 = l31 * 256 + ((hh ^ (l31 & 15)) * 16);
  const int VO0 = 16384 + l31 * 128 + ((hh ^ ((l31 >> 1) & 7)) * 16);
  const int nsteps = 4 * qb + 4;
  asm volatile("s_waitcnt vmcnt(0)" ::: "memory");
  __syncthreads();
  { const int j0 = nsteps - 1; SB_DMA(j0, 0); SB_DMA((j0 > 0 ? j0 - 1 : 0), 1); SB_DMA((j0 > 1 ? j0 - 2 : 0), 2); }
#pragma unroll 1
  for (int n = 0; n < nsteps; ++n) {
    const int j = nsteps - 1 - n, buf = n & 3;
    asm volatile("s_waitcnt vmcnt(8)" ::: "memory");
    __builtin_amdgcn_s_barrier();
    asm volatile("" ::: "memory");
    { const int jn = j > 3 ? j - 3 : 0; SB_DMA(jn, (n + 3) & 3); }
    const char* lb_ = smem + buf * 32768;
    int ko0 = KO0, vo0 = VO0;
    asm volatile("" : "+v"(ko0), "+v"(vo0));
    if (2 * j + 1 == qt) sb_tile<true>(lb_ + 32 * 256, lb_, ko0, vo0 ^ 64, qf, O, accp, l31, hh);
    else if (2 * j + 1 < qt) sb_tile<false>(lb_ + 32 * 256, lb_, ko0, vo0 ^ 64, qf, O, accp, l31, hh);
    if (2 * j == qt) sb_tile<true>(lb_, lb_, ko0, vo0, qf, O, accp, l31, hh);
    else if (2 * j < qt) sb_tile<false>(lb_, lb_, ko0, vo0, qf, O, accp, l31, hh);
    asm volatile("" ::: "memory");
  }
  asm volatile("s_waitcnt vmcnt(0)" ::: "memory");
#undef SB_DMA
  __syncthreads();
  {
    char* lw = smem + wave * 16384;
#pragma unroll
    for (int d = 0; d < 4; ++d)
#pragma unroll
      for (int q = 0; q < 4; ++q) {
        const f32x4 o = {O[d][4 * q], O[d][4 * q + 1], O[d][4 * q + 2], O[d][4 * q + 3]};
        *(f32x4*)(lw + l31 * 512 + (((8 * d + 2 * q + hh) ^ l31) * 16)) = o;
      }
    asm volatile("s_waitcnt lgkmcnt(0)" ::: "memory");
    const size_t tok0 = row0 + qt * 32;
    u32x2 gv[16];
#pragma unroll
    for (int i = 0; i < 16; ++i) { const int r = 2 * i + hh, c = l31 ^ r; gv[i] = *(const u32x2*)(ssg + (tok0 + r) * 2048 + h * 128 + 4 * c); }
#pragma unroll
    for (int i = 0; i < 16; ++i) {
      const int r = 2 * i + hh, c = l31 ^ r;
      const f32x4 o = *(const f32x4*)(lw + r * 512 + l31 * 16);
      *(u32x2*)(ob + (tok0 + r) * 2048 + h * 128 + 4 * c) = pk4(o * unpk4(gv[i]));
    }
  }
  panel_publish((unsigned*)(p.ws + OFF_MISC + 2048 + 896) + (b * 8 + qb), tidx);
  __syncthreads();
}

DEV void mem_block(const Params& p, int item) {
  const int tidx = otid();
  const int wave = __builtin_amdgcn_readfirstlane(tidx >> 6), lane = tidx & 63, l31 = lane & 31, hh = lane >> 5;
  const int h = item & 3, qblk = item >> 2, qt = qblk * 8 + wave, b = qblk >> 3;
  const size_t tok = (size_t)qt * 32 + l31;
  const bf16_t* qp = (const bf16_t*)(p.ws + OFF_MQ) + tok * 2048 + h * 512 + 8 * hh;
  const bf16_t* ksrc = (const bf16_t*)(p.ws + OFF_MK) + ((size_t)(b * 256 + (lane >> 3))) * 2048 + h * 512;
  const bf16_t* vsrc = (const bf16_t*)(p.ws + OFF_MVT) + ((size_t)(b * 2048 + h * 512 + (lane >> 5))) * 256;
  bf16_t* om = (bf16_t*)(p.ws + OFF_OM);
#define MEM_DMA(n_, buf_) do { \
    _Pragma("unroll") for (int i_ = 0; i_ < 4; ++i_) { const int k_ = wave * 4 + i_; \
      if ((n_) < 8) { const int r_ = 8 * k_ + (lane >> 3); \
        GLDS16(ksrc + (size_t)(8 * k_) * 2048 + 64 * (n_) + (((lane & 7) ^ ((r_ >> 1) & 7)) * 8), smem + (buf_) * 32768 + k_ * 1024 + lane * 16); } \
      else { const int r_ = 2 * k_ + (lane >> 5); \
        GLDS16(vsrc + (size_t)(64 * ((n_) - 8) + 2 * k_) * 256 + (((lane & 31) ^ (r_ & 31)) * 8), smem + (buf_) * 32768 + k_ * 1024 + lane * 16); } } } while (0)
  const int KF0 = l31 * 128 + ((hh ^ ((l31 >> 1) & 7)) * 16);
  f32x16 Sx[8];
#pragma unroll
  for (int t = 0; t < 8; ++t) for (int g = 0; g < 16; ++g) Sx[t][g] = 0.f;
  asm volatile("s_waitcnt vmcnt(0)" ::: "memory");
  __syncthreads();
  bf16x8 bq[3][4];
#pragma unroll
  for (int kq = 0; kq < 4; ++kq) bq[0][kq] = ld16(qp + 16 * kq);
  MEM_DMA(0, 0);
#pragma unroll
  for (int kq = 0; kq < 4; ++kq) bq[1][kq] = ld16(qp + 64 + 16 * kq);
  MEM_DMA(1, 1);
#pragma unroll
  for (int n = 0; n < 8; ++n) {
    const int buf = n % 3, nb = (n + 2) % 3;
    asm volatile("s_waitcnt vmcnt(8)" ::: "memory");
    __builtin_amdgcn_s_barrier();
    asm volatile("" ::: "memory");
    {
      const int nq = n + 2 < 8 ? n + 2 : 7;
#pragma unroll
      for (int kq = 0; kq < 4; ++kq) bq[nb][kq] = ld16(qp + 64 * nq + 16 * kq);
    }
    MEM_DMA(n + 2, nb);
    const char* lf = smem + buf * 32768;
    int kf0 = KF0;
    asm volatile("" : "+v"(kf0));
#pragma unroll
    for (int kq = 0; kq < 4; ++kq) {
      bf16x8 kf[8];
#pragma unroll
      for (int t = 0; t < 8; ++t) kf[t] = *(const bf16x8*)(lf + t * 4096 + (kf0 ^ (32 * kq)));
      __builtin_amdgcn_sched_barrier(0);
#pragma unroll
      for (int t = 0; t < 8; ++t) Sx[t] = mfma32(kf[t], bq[buf][kq], Sx[t]);
    }
    asm volatile("" ::: "memory");
  }
  int buf = 8 % 3;
  float mx = -1e30f;
#pragma unroll
  for (int t = 0; t < 8; ++t) for (int g = 0; g < 16; ++g) mx = fmaxf(mx, Sx[t][g]);
  mx = fmaxf(mx, __shfl_xor(mx, 32));
  float sum = 0.f;
#pragma unroll
  for (int t = 0; t < 8; ++t) for (int g = 0; g < 16; ++g) { const float e = __expf(Sx[t][g] - mx); Sx[t][g] = e; sum += e; }
  sum += __shfl_xor(sum, 32);
  const float inv = 1.f / sum;
  bf16x8 pf[8][2];
#pragma unroll
  for (int t = 0; t < 8; ++t) { pf[t][0] = cvt8<0>(Sx[t]); pf[t][1] = cvt8<1>(Sx[t]); }
  const int VF0 = l31 * 512 + ((hh ^ l31) * 16);
#pragma unroll 1
  for (int n = 8; n < 16; ++n) {
    if (n == 8) asm volatile("s_waitcnt vmcnt(4)" ::: "memory");
    else if (n == 9) asm volatile("s_waitcnt vmcnt(8)" ::: "memory");
    else asm volatile("s_waitcnt vmcnt(12)" ::: "memory");
    __builtin_amdgcn_s_barrier();
    asm volatile("" ::: "memory");
    const int nb = buf >= 1 ? buf - 1 : 2;
    { const int nn = n + 2 < 16 ? n + 2 : 15; MEM_DMA(nn, nb); }
    const char* lf = smem + buf * 32768;
    int vf0 = VF0;
    asm volatile("" : "+v"(vf0));
    char* lw = smem + 98304 + wave * 4096;
#pragma unroll
    for (int dd = 0; dd < 2; ++dd) {
      f32x16 o;
      for (int g = 0; g < 16; ++g) o[g] = 0.f;
#pragma unroll
      for (int t = 0; t < 8; ++t) { o = mfma32(*(const bf16x8*)(lf + dd * 16384 + (vf0 ^ (64 * t))), pf[t][0], o); o = mfma32(*(const bf16x8*)(lf + dd * 16384 + (vf0 ^ (64 * t + 32))), pf[t][1], o); }
#pragma unroll
      for (int q = 0; q < 4; ++q) {
        f32x4 v = {o[4 * q] * inv, o[4 * q + 1] * inv, o[4 * q + 2] * inv, o[4 * q + 3] * inv};
        *(u32x2*)(lw + l31 * 128 + (((4 * dd + q) ^ (l31 & 7)) * 16) + hh * 8) = pk4(v);
      }
    }
    asm volatile("s_waitcnt lgkmcnt(0)" ::: "memory");
#pragma unroll
    for (int i = 0; i < 4; ++i) {
      const int id = i * 64 + lane, r = id >> 3, pos = id & 7, c = pos ^ (r & 7);
      *(u32x4*)(om + ((size_t)qt * 32 + r) * 2048 + h * 512 + 64 * (n - 8) + 8 * c) = *(const u32x4*)(lw + r * 128 + pos * 16);
    }
    buf = buf == 2 ? 0 : buf + 1;
    asm volatile("" ::: "memory");
  }
#undef MEM_DMA
  panel_publish((unsigned*)(p.ws + OFF_MISC + 2048 + 896) + qblk, tidx);
  __syncthreads();
}

DEV void phase2(const Params& p, int rerun) {
  const int tidx = otid();
  const int parts = rerun ? PROBE_PART : 7;
  if (parts & 1) for (int g = blockIdx.x; g < 64; g += gridDim.x) gla_block(p, g);
  unsigned* ctr = (unsigned*)(p.ws + OFF_MISC + (rerun ? 256 : 0));
  volatile int* slot = (volatile int*)(smem + 131072 + 2048);
  unsigned* mkv_done = (unsigned*)(p.ws + OFF_MISC + 1024);
  const int nstatic = ((parts & 1) && gridDim.x > 64) ? (int)gridDim.x - 64 : ((parts & 1) ? 0 : (int)gridDim.x);
  bool first = ((parts & 1) ? (int)blockIdx.x >= 64 && nstatic > 0 : true);
  const int firstit = (parts & 1) ? (int)blockIdx.x - 64 : (int)blockIdx.x;
  while (true) {
    __syncthreads();
    if (tidx == 0) *slot = first ? firstit : (int)(nstatic + atomicAdd(ctr, 1u));
    first = false;
    __syncthreads();
    const int it = __builtin_amdgcn_readfirstlane(*slot);
    if (it >= 64 + 512 + 128) break;
    if (it < 64) {
      phase1(p, 2816 + it);
      __threadfence();
      __syncthreads();
      if (tidx == 0) atomicAdd(mkv_done, 1u);
    } else if (it < 64 + 320) { if (parts & 2) sb_block(p, it - 64); }
    else if (it >= 64 + 320 + 128) { if (parts & 2) sb_block(p, it - 64 - 128); }
    else {
      if (tidx == 0) {
        while (__hip_atomic_load(mkv_done, __ATOMIC_RELAXED, __HIP_MEMORY_SCOPE_AGENT) < 64u) __builtin_amdgcn_s_sleep(8);
        __builtin_amdgcn_fence(__ATOMIC_ACQUIRE, "agent");
      }
      __syncthreads();
      if (parts & 4) mem_block(p, it - 64 - 320);
    }
  }
}

DEV void phase25(const Params& p, const bool fuse) {
  const int tidx = otid();
  const int wave = __builtin_amdgcn_readfirstlane(tidx >> 6), lane = tidx & 63, l31 = lane & 31, hh = lane >> 5;
  const bf16_t* Qp = (const bf16_t*)(p.ws + OFF_QP);
  const bf16_t* Kd = (const bf16_t*)(p.ws + OFF_KDP);
  const bf16_t* gvT = (const bf16_t*)(p.ws + OFF_GVT);
  const bf16_t* sgg = (const bf16_t*)(p.ws + OFF_SGG);
  const float* op0 = (const float*)(p.ws + OFF_OP0);
  const float* op1 = (const float*)(p.ws + OFF_OP1);
  bf16_t* oa = (bf16_t*)(p.ws + OFF_OA);
  float* ssL = (float*)(smem + 131072 + 3072);
  unsigned* ctr25 = (unsigned*)(p.ws + OFF_MISC + 1280);
  volatile int* slot25 = (volatile int*)(smem + 131072 + 2048);
  int itn = blockIdx.x;
#pragma unroll 1
  for (;;) {
    int it;
    if (fuse) {
      __syncthreads();
      if (tidx == 0) *slot25 = (int)atomicAdd(ctr25, 1u);
      __syncthreads();
      it = __builtin_amdgcn_readfirstlane(*slot25);
    } else { it = itn; itn += gridDim.x; }
    if (it >= 512) break;
    const int bh = it >> 5, c = it & 31, b = bh >> 2, h = bh & 3, tok0 = c * 64;
    const size_t grow = (size_t)b * 2048 + tok0;
    if (fuse) panel_wait((unsigned*)(p.ws + OFF_MISC + 2048 + 768) + bh, 4u, tidx);
    if (tidx < 64) ssL[tidx] = 0.f;
    if (wave < 3) {
      const int jt = (wave == 2) ? 1 : 0, i2 = (wave == 0) ? 0 : 1;
      const bf16_t* kd = Kd + (grow + 32 * jt + l31) * 1024 + h * 256 + 8 * hh;
      const bf16_t* q = Qp + (grow + 32 * i2 + l31) * 1024 + h * 256 + 8 * hh;
      f32x16 X;
      for (int g = 0; g < 16; ++g) X[g] = 0.f;
#pragma unroll
      for (int s = 0; s < 16; ++s) X = mfma32(ld16(kd + 16 * s), ld16(q + 16 * s), X);
      if (jt == i2) {
#pragma unroll
        for (int g = 0; g < 16; ++g) { const int jl = (g & 3) + 8 * (g >> 2) + 4 * hh; if (jl > l31) X[g] = 0.f; }
      }
      *(bf16x8*)(smem + (wave * 2 + 0) * 1024 + lane * 16) = cvt8<0>(X);
      *(bf16x8*)(smem + (wave * 2 + 1) * 1024 + lane * 16) = cvt8<1>(X);
    }
    f32x16 o[2][2];
#pragma unroll
    for (int dt = 0; dt < 2; ++dt)
#pragma unroll
      for (int i2 = 0; i2 < 2; ++i2)
#pragma unroll
        for (int q = 0; q < 4; ++q) {
          const size_t idx = ((((size_t)((b * 32 + c) * 4 + h) * 16 + (2 * wave + dt)) * 2 + i2) * 4 + q) * 64 + lane;
          const f32x4 a = unpk4(((const u32x2*)op0)[idx]);
          for (int j = 0; j < 4; ++j) o[dt][i2][4 * q + j] = a[j];
        }
    bf16x8 vfr[2][4];
#pragma unroll
    for (int dt = 0; dt < 2; ++dt)
#pragma unroll
      for (int s4 = 0; s4 < 4; ++s4) vfr[dt][s4] = ld16(gvT + ((size_t)(b * 2048 + h * 512 + 64 * wave + 32 * dt + l31)) * 2048 + tok0 + 16 * s4 + 8 * hh);
    __syncthreads();
    {
      const char* lx = smem + lane * 16;
      const bf16x8 x00a = *(const bf16x8*)(lx), x00b = *(const bf16x8*)(lx + 1024), x01a = *(const bf16x8*)(lx + 2048), x01b = *(const bf16x8*)(lx + 3072),
                   x11a = *(const bf16x8*)(lx + 4096), x11b = *(const bf16x8*)(lx + 5120);
#pragma unroll
      for (int dt = 0; dt < 2; ++dt) {
        o[dt][0] = mfma32(vfr[dt][0], x00a, o[dt][0]); o[dt][0] = mfma32(vfr[dt][1], x00b, o[dt][0]);
        o[dt][1] = mfma32(vfr[dt][0], x01a, o[dt][1]); o[dt][1] = mfma32(vfr[dt][1], x01b, o[dt][1]);
        o[dt][1] = mfma32(vfr[dt][2], x11a, o[dt][1]); o[dt][1] = mfma32(vfr[dt][3], x11b, o[dt][1]);
      }
    }
#pragma unroll
    for (int i2 = 0; i2 < 2; ++i2) {
      float ss = 0.f;
#pragma unroll
      for (int dt = 0; dt < 2; ++dt) for (int g = 0; g < 16; ++g) ss += o[dt][i2][g] * o[dt][i2][g];
      ss += __shfl_xor(ss, 32);
      if (hh == 0) atomicAdd(&ssL[32 * i2 + l31], ss);
    }
    __syncthreads();
    {
      char* lw = smem + wave * 16384;
#pragma unroll
      for (int dt = 0; dt < 2; ++dt)
#pragma unroll
        for (int i2 = 0; i2 < 2; ++i2)
#pragma unroll
          for (int q = 0; q < 4; ++q) {
            const f32x4 v = {o[dt][i2][4 * q], o[dt][i2][4 * q + 1], o[dt][i2][4 * q + 2], o[dt][i2][4 * q + 3]};
            const int r = 32 * i2 + l31;
            *(f32x4*)(lw + r * 256 + (((8 * dt + 2 * q + hh) ^ (r & 15)) * 16)) = v;
          }
      asm volatile("s_waitcnt lgkmcnt(0)" ::: "memory");
      u32x2 sgv[16]; f32x4 ghv[16];
#pragma unroll
      for (int i = 0; i < 16; ++i) {
        const int id = i * 64 + lane, r = id >> 4, pos = id & 15, c = pos ^ (r & 15);
        const int dv = 64 * wave + 4 * c;
        sgv[i] = *(const u32x2*)(sgg + (grow + r) * 2048 + h * 512 + dv);
        ghv[i] = *(const f32x4*)(p.g_head + dv);
      }
#pragma unroll
      for (int i = 0; i < 16; ++i) {
        const int id = i * 64 + lane, r = id >> 4, pos = id & 15, c = pos ^ (r & 15);
        const f32x4 v = *(const f32x4*)(lw + r * 256 + pos * 16);
        const float rstd = rsqrtf(ssL[r] * (1.f / 512.f) + 1e-6f);
        const int dv = 64 * wave + 4 * c;
        *(u32x2*)(oa + (grow + r) * 2048 + h * 512 + dv) = pk4(v * rstd * ghv[i] * unpk4(sgv[i]));
      }
    }
    __syncthreads();
    if (fuse) panel_publish((unsigned*)(p.ws + OFF_MISC + 2048 + 512) + (b * 8 + (c >> 2)), tidx);
  }
}

DEV void phase3(const Params& p, const bool fuse) {
  EpiMerge e; e.gates = (const bf16_t*)(p.ws + OFF_GATES); e.mg = (float*)(p.ws + OFF_MERGED); e.mbf = (bf16_t*)(p.ws + OFF_MBF);
  unsigned* cnt3 = (unsigned*)(p.ws + OFF_MISC + 2048 + 256);
  for (int L = blockIdx.x; L < 256; L += gridDim.x) {
    const int xcd = L & 7, off = L >> 3, wgid = xcd * 32 + off;
    const int pm = wgid >> 3, pn = wgid & 7;
    const int brow = pm * 256, bcol = pn * 256;
#pragma unroll 1
    for (int step = 0; step < 3; ++step) {
      const bf16_t* a = (const bf16_t*)(p.ws + (step == 0 ? OFF_OB : step == 1 ? OFF_OM : OFF_OA));
      const bf16_t* w = (const bf16_t*)(p.ws + (step == 0 ? OFF_WT_PS : step == 1 ? OFF_WT_PM : OFF_WT_PG));
      if (fuse && step == 0) panel_wait((unsigned*)(p.ws + OFF_MISC + 2048 + 896) + pm, 20u, otid());
      if (fuse && step == 2) panel_wait((unsigned*)(p.ws + OFF_MISC + 2048 + 512) + pm, 16u, otid());
      e.step = step; e.gidx = (step == 0 ? 1 : step == 1 ? 2 : 0);
      gemm_tile<true>(a, w, 2048, brow, bcol, e);
    }
    if (fuse) panel_publish(cnt3 + pm, otid());
  }
}
DEV void p5_rowpair(const Params& p, const int row0, const int lane) {
  const bf16_t* y = (const bf16_t*)(p.ws + OFF_Y);
  const float* part = (const float*)(p.ws + OFF_PART);
  float ss0 = (lane < 32) ? part[(size_t)lane * NTOK + row0] : 0.f;
  float ss1 = (lane < 32) ? part[(size_t)lane * NTOK + row0 + 1] : 0.f;
  u32x2 yv[2][8]; f32x4 xv[2][8];
#pragma unroll
  for (int r = 0; r < 2; ++r)
#pragma unroll
    for (int i = 0; i < 8; ++i) {
      const size_t idx = (size_t)(row0 + r) * DM + 4 * (lane + 64 * i);
      yv[r][i] = *(const u32x2*)(y + idx); xv[r][i] = *(const f32x4*)(p.x + idx);
    }
  ss0 = wave_sum(ss0); ss1 = wave_sum(ss1);
  const float rs[2] = {rsqrtf(ss0 * (1.f / DM) + 1e-6f), rsqrtf(ss1 * (1.f / DM) + 1e-6f)};
#pragma unroll
  for (int i = 0; i < 8; ++i) {
    const f32x4 g = *(const f32x4*)(p.g_post + 4 * (lane + 64 * i));
#pragma unroll
    for (int r = 0; r < 2; ++r) {
      const size_t idx = (size_t)(row0 + r) * DM + 4 * (lane + 64 * i);
      *(f32x4*)(p.out + idx) = xv[r][i] + unpk4(yv[r][i]) * rs[r] * g;
    }
  }
}
DEV void phase4(const Params& p, const bool fuse) {
  EpiOut e; e.y = (bf16_t*)(p.ws + OFF_Y); e.part = (float*)(p.ws + OFF_PART);
  unsigned* cnt = (unsigned*)(p.ws + OFF_MISC + 2048);
  unsigned* cnt3 = (unsigned*)(p.ws + OFF_MISC + 2048 + 256);
  for (int L = blockIdx.x; L < 256; L += gridDim.x) {
    const int xcd = L & 7, off = L >> 3, wgid = xcd * 32 + off;
    const int pm = wgid >> 3, pn = wgid & 7;
    const int tidx = otid();
    if (fuse) panel_wait(cnt3 + pm, 8u, tidx);
    gemm_tile<true>((const bf16_t*)(p.ws + OFF_MBF), (const bf16_t*)(p.ws + OFF_WT_OUT), 2048, pm * 256, pn * 256, e);
    if (fuse) {
      panel_publish(cnt + pm, tidx);
      panel_wait(cnt + pm, 8u, tidx);
      const int wave = tidx >> 6, lane = tidx & 63;
      const int rbase = pm * 256 + pn * 32 + wave * 4;
      p5_rowpair(p, rbase, lane);
      p5_rowpair(p, rbase + 2, lane);
    }
  }
}
DEV void phase5(const Params& p) {
  const int tidx = otid();
  const int lane = tidx & 63;
  const int gw = blockIdx.x * 8 + (tidx >> 6), nw = gridDim.x * 8;
  for (int row0 = gw * 2; row0 < NTOK; row0 += nw * 2) p5_rowpair(p, row0, lane);
}

__global__ void __launch_bounds__(512) hybrid_layer_megakernel(Params p, int ph_lo, int ph_hi) {
  if (ph_hi == 6 && gridDim.x >= 256) ph_hi = 2;
  for (int ph = ph_lo; ph <= ph_hi; ++ph) {
    for (int rep = 0; rep < ((ph == PROBE_DUP) ? 2 : 1); ++rep) {
      if (rep) cg::this_grid().sync();
      switch (ph) {
        case 0: phase0(p); break;
        case 1: phase1(p, -1); break;
        case 2: phase2(p, rep); if (gridDim.x >= 256) { phase25(p, true); phase3(p, true); phase4(p, true); } break;
        case 3: if (gridDim.x < 256) phase25(p, false); break;
        case 4: if (gridDim.x < 256) phase3(p, false); break;
        case 5: if (gridDim.x < 256) phase4(p, false); break;
        default: if (gridDim.x < 256) phase5(p); break;
      }
    }
    if (ph < ph_hi) { cg::this_grid().sync(); }
  }
}

extern "C" void kernel_launch(void* const* d_in, const int* in_sizes, int n_in, void* d_out, int out_size, void* d_ws, size_t ws_size,
                              hipStream_t stream) {
  constexpr size_t kDynLds = 131072 + 4096 + 16384;
  static int grid_blocks = 0;
  if (!grid_blocks) {
    hipFuncSetAttribute((const void*)hybrid_layer_megakernel, hipFuncAttributeMaxDynamicSharedMemorySize, (int)kDynLds);
    int dev = 0, cus = 0, per_cu = 0;
    hipGetDevice(&dev);
    hipDeviceGetAttribute(&cus, hipDeviceAttributeMultiprocessorCount, dev);
    hipOccupancyMaxActiveBlocksPerMultiprocessor(&per_cu, hybrid_layer_megakernel, 512, kDynLds);
    if (per_cu < 1) per_cu = 1;
    if (per_cu > 1) per_cu = 1;
    grid_blocks = cus * per_cu;
  }
  Params p{};
  p.x = (const float*)d_in[0]; p.mem = (const float*)d_in[1]; p.g_pre = (const float*)d_in[2]; p.g_post = (const float*)d_in[3];
  p.g_mem = (const float*)d_in[4]; p.w_in = (const float*)d_in[5]; p.a_w2 = (const float*)d_in[6]; p.a_b = (const float*)d_in[7];
  p.g_head = (const float*)d_in[8]; p.w_mkv = (const float*)d_in[9]; p.w_pg = (const float*)d_in[10]; p.w_ps = (const float*)d_in[11];
  p.w_pm = (const float*)d_in[12]; p.w_out = (const float*)d_in[13];
  p.out = (float*)d_out; p.ws = (char*)d_ws;
  hipMemsetAsync((char*)d_ws + OFF_MISC, 0, 4096, stream);
#if MK_MULTI
  for (int ph = 0; ph <= 6; ++ph) hipLaunchKernelGGL(hybrid_layer_megakernel, dim3(grid_blocks), dim3(512), kDynLds, stream, p, ph, ph);
#else
  int lo = 0, hi = 6;
  void* args[] = {&p, &lo, &hi};
  hipError_t e = hipLaunchCooperativeKernel((const void*)hybrid_layer_megakernel, dim3(grid_blocks), dim3(512), args, kDynLds, stream);
  if (e != hipSuccess) fprintf(stderr, "cooperative launch failed: %s (grid %d)\n", hipGetErrorString(e), grid_blocks);
#endif
}
```

```cpp
#include <hip/hip_runtime.h>
#include <hip/hip_cooperative_groups.h>
#include <cstdio>
namespace cg = cooperative_groups;

#ifndef PROBE_DUP
#define PROBE_DUP -1
#endif
#ifndef PROBE_PART
#define PROBE_PART 7
#endif
#ifndef MK_MULTI
#define MK_MULTI 0
#endif

typedef unsigned short bf16_t;
typedef short bf16x8 __attribute__((ext_vector_type(8)));
typedef float f32x2 __attribute__((ext_vector_type(2)));
typedef float f32x4 __attribute__((ext_vector_type(4)));
typedef float f32x16 __attribute__((ext_vector_type(16)));
typedef unsigned u32x2 __attribute__((ext_vector_type(2)));
typedef unsigned u32x4 __attribute__((ext_vector_type(4)));
typedef __bf16 bf16x2_t __attribute__((ext_vector_type(2)));
#define DEV __device__ __forceinline__

constexpr int NTOK = 8192, DM = 2048, NPROJ = 22528;
constexpr size_t MiB = 1048576;
constexpr size_t OFF_WT_IN = 0, OFF_WT_MKV = 88 * MiB, OFF_WT_PG = 104 * MiB, OFF_WT_PS = 112 * MiB, OFF_WT_PM = 120 * MiB, OFF_WT_OUT = 128 * MiB,
                 OFF_H = 136 * MiB, OFF_MEMH = 168 * MiB, OFF_B = 172 * MiB, OFF_EB = 204 * MiB, OFF_MISC = 206 * MiB,
                 OFF_QP = 208 * MiB, OFF_KDP = 224 * MiB, OFF_KET = 240 * MiB, OFF_GVT = 256 * MiB, OFF_SGG = 288 * MiB, OFF_SQ = 320 * MiB,
                 OFF_SK = 352 * MiB, OFF_SVT = 384 * MiB, OFF_SSG = 416 * MiB, OFF_MQ = 448 * MiB, OFF_GATES = 480 * MiB, OFF_MK = 576 * MiB,
                 OFF_MVT = 580 * MiB;
constexpr size_t OFF_OP0 = OFF_WT_IN, OFF_OP1 = 584 * MiB, OFF_OB = OFF_H, OFF_OM = OFF_B, OFF_OA = 32 * MiB, OFF_MERGED = 584 * MiB, OFF_MBF = 616 * MiB, OFF_Y = 648 * MiB;
constexpr size_t OFF_PART = OFF_MISC + 4096;

struct Params {
  const float *x, *mem, *g_pre, *g_post, *g_mem, *w_in, *a_w2, *a_b, *g_head, *w_mkv, *w_pg, *w_ps, *w_pm, *w_out;
  float* out; char* ws;
};

extern __shared__ __attribute__((aligned(16))) char smem[];

DEV unsigned pk_bf16(float a, float b) { f32x2 v = {a, b}; bf16x2_t r = __builtin_convertvector(v, bf16x2_t); return __builtin_bit_cast(unsigned, r); }
DEV float bf_lo(unsigned u) { return __uint_as_float(u << 16); }
DEV float bf_hi(unsigned u) { return __uint_as_float(u & 0xffff0000u); }
DEV float wave_sum(float v) { for (int o = 32; o; o >>= 1) v += __shfl_xor(v, o); return v; }
DEV bf16x8 ld16(const bf16_t* p) { return *(const bf16x8*)p; }
DEV f32x16 mfma32(bf16x8 a, bf16x8 b, f32x16 c) { return __builtin_amdgcn_mfma_f32_32x32x16_bf16(a, b, c, 0, 0, 0); }
template <int S> DEV bf16x8 cvt8(const f32x16& v) {
  u32x4 p = {pk_bf16(v[8 * S], v[8 * S + 1]), pk_bf16(v[8 * S + 2], v[8 * S + 3]), pk_bf16(v[8 * S + 4], v[8 * S + 5]), pk_bf16(v[8 * S + 6], v[8 * S + 7])};
  return __builtin_bit_cast(bf16x8, p);
}
DEV u32x2 pk4(f32x4 v) { u32x2 r = {pk_bf16(v[0], v[1]), pk_bf16(v[2], v[3])}; return r; }
DEV f32x4 unpk4(u32x2 u) { f32x4 r = {bf_lo(u[0]), bf_hi(u[0]), bf_lo(u[1]), bf_hi(u[1])}; return r; }
DEV int sig4(int x) { return ((x & 1) << 1) | (x >> 1); }
DEV int sig16(int p) { return 8 * ((p >> 2) & 1) + 4 * (p >> 3) + (p & 3); }
DEV int otid() { int t = threadIdx.x; asm volatile("" : "+v"(t)); return t; }
DEV float fsigmoid(float x) { return 1.f / (1.f + __expf(-x)); }
DEV float logsigmoid(float x) { return fminf(x, 0.f) - __logf(1.f + __expf(-fabsf(x))); }

constexpr int BM = 256, BK = 64, HALF = 128, HT = HALF * BK;
DEV int lds_byte(int r, int c) { int st = (r >> 4) * 2 + (c >> 5), rr = r & 15, cc = c & 31, ob = rr * 64 + cc * 2; return st * 1024 + (ob ^ (((ob >> 9) & 1) << 5)); }
DEV void stage_rc(int b, int& R, int& C) { int st = b / 1024, sb = b % 1024, swz = sb ^ (((sb >> 9) & 1) << 5); R = (st >> 1) * 16 + swz / 64; C = (st & 1) * 32 + (swz % 64) / 2; }

template <bool SWAP, class Epi>
DEV void gemm_tile(const bf16_t* __restrict__ A, const bf16_t* __restrict__ Bt, const int K, const int brow, const int bcol, const Epi& epi) {
  bf16_t* shm = (bf16_t*)smem;
#define SA(b, h) (shm + ((b) * 2 + (h)) * HT)
#define SB(b, h) (shm + (4 + (b) * 2 + (h)) * HT)
#define STAGE(P, BASE, br, kt) do { const char* _gb = (const char*)(BASE) + (((long)(br) * K + (long)(kt) * BK) << 1); \
    __builtin_amdgcn_global_load_lds((const unsigned*)(_gb + so0), (unsigned*)((char*)(P) + tb), 16, 0, 0); \
    __builtin_amdgcn_global_load_lds((const unsigned*)(_gb + so1), (unsigned*)((char*)(P) + tb + 8192), 16, 0, 0); } while (0)
#define LDA(dst, b, h) for (int m = 0; m < 4; ++m) for (int k = 0; k < 2; ++k) \
    dst[m][k] = *reinterpret_cast<const bf16x8*>((char*)SA(b, h) + a_rd + m * 2048 + k * 1024)
#define LDB(dst, b, h) for (int n = 0; n < 2; ++n) for (int k = 0; k < 2; ++k) \
    dst[n][k] = *reinterpret_cast<const bf16x8*>((char*)SB(b, h) + b_rd + n * 2048 + k * 1024)
#define MMA(ai, bj, At_, Bt_) do { __builtin_amdgcn_s_setprio(1); \
    for (int m = 0; m < 4; ++m) for (int n = 0; n < 2; ++n) for (int k = 0; k < 2; ++k) \
      acc[ai][bj][m][n] = SWAP ? __builtin_amdgcn_mfma_f32_16x16x32_bf16(Bt_[n][k], At_[m][k], acc[ai][bj][m][n], 0, 0, 0) \
                               : __builtin_amdgcn_mfma_f32_16x16x32_bf16(At_[m][k], Bt_[n][k], acc[ai][bj][m][n], 0, 0, 0); \
    __builtin_amdgcn_s_setprio(0); } while (0)
#define WAIT_V(n) asm volatile("s_waitcnt vmcnt(" #n ")" ::: "memory")
#define WAIT_L(n) asm volatile("s_waitcnt lgkmcnt(" #n ")" ::: "memory")
#define BAR __builtin_amdgcn_s_barrier()
#define SCHED __builtin_amdgcn_sched_barrier(0)
  const int tidx = otid();
  const int wid = tidx >> 6, lane = tidx & 63, wr = wid >> 2, wc = wid & 3, fr = lane & 15, fq = lane >> 4;
  f32x4 acc[2][2][4][2] = {};
  bf16x8 At[4][2], B0[2][2], B1[2][2];
  const int nt = K / BK;
  const int tb = tidx * 16;
  unsigned so0, so1;
  { int r_, c_; stage_rc(tb, r_, c_); so0 = (unsigned)(r_ * K + c_) * 2u; stage_rc(tb + 8192, r_, c_); so1 = (unsigned)(r_ * K + c_) * 2u; }
  const int tb16 = (fr * 64 + fq * 16) ^ ((fr >> 3) << 5);
  const int a_rd = wr * 8192 + tb16, b_rd = wc * 4096 + tb16;
  WAIT_V(0);
  __syncthreads();
  STAGE(SB(0, 0), Bt, bcol, 0); STAGE(SA(0, 0), A, brow, 0);
  STAGE(SB(0, 1), Bt, bcol + HALF, 0); STAGE(SA(0, 1), A, brow + HALF, 0);
  if (wr == 1) BAR;
  WAIT_V(4); BAR;
  STAGE(SB(1, 0), Bt, bcol, 1); STAGE(SA(1, 0), A, brow, 1); STAGE(SB(1, 1), Bt, bcol + HALF, 1);
  WAIT_V(6); BAR;
#pragma unroll 1
  for (int t = 0; t < nt - 2; t += 2) {
    LDB(B0, 0, 0); SCHED; LDA(At, 0, 0); STAGE(SA(1, 1), A, brow + HALF, t + 1);
    WAIT_L(8); BAR; WAIT_L(0); MMA(0, 0, At, B0); BAR; SCHED;
    LDB(B1, 0, 1); STAGE(SB(0, 0), Bt, bcol, t + 2);
    BAR; WAIT_L(0); MMA(0, 1, At, B1); BAR;
    LDA(At, 0, 1); STAGE(SA(0, 0), A, brow, t + 2);
    BAR; WAIT_L(0); MMA(1, 0, At, B0); BAR; SCHED;
    STAGE(SB(0, 1), Bt, bcol + HALF, t + 2);
    WAIT_V(6); BAR; MMA(1, 1, At, B1); BAR;
    LDB(B0, 1, 0); SCHED; LDA(At, 1, 0); STAGE(SA(0, 1), A, brow + HALF, t + 2);
    WAIT_L(8); BAR; WAIT_L(0); MMA(0, 0, At, B0); BAR; SCHED;
    LDB(B1, 1, 1); STAGE(SB(1, 0), Bt, bcol, t + 3);
    BAR; WAIT_L(0); MMA(0, 1, At, B1); BAR;
    LDA(At, 1, 1); STAGE(SA(1, 0), A, brow, t + 3);
    BAR; WAIT_L(0); MMA(1, 0, At, B0); BAR; SCHED;
    STAGE(SB(1, 1), Bt, bcol + HALF, t + 3);
    WAIT_V(6); BAR; MMA(1, 1, At, B1); BAR;
  }
  { LDB(B0, 0, 0); LDA(At, 0, 0); STAGE(SA(1, 1), A, brow + HALF, nt - 1);
    BAR; WAIT_L(0); MMA(0, 0, At, B0); BAR;
    LDB(B1, 0, 1); BAR; WAIT_L(0); MMA(0, 1, At, B1); BAR;
    LDA(At, 0, 1); WAIT_V(4); BAR; WAIT_L(0); MMA(1, 0, At, B0); MMA(1, 1, At, B1); BAR; }
  { LDB(B0, 1, 0); LDA(At, 1, 0); WAIT_V(2); BAR; WAIT_L(0); MMA(0, 0, At, B0); BAR;
    LDB(B1, 1, 1); WAIT_V(0); BAR; WAIT_L(0); MMA(0, 1, At, B1); BAR;
    LDA(At, 1, 1); BAR; WAIT_L(0); MMA(1, 0, At, B0); MMA(1, 1, At, B1); BAR; }
  if (wr == 0) BAR;
  {
    int tx = tidx, br2 = brow, bc2 = bcol;
    asm volatile("" : "+v"(tx), "+s"(br2), "+s"(bc2));
    const int wid2 = tx >> 6, lane2 = tx & 63;
    epi(acc, br2, bc2, wid2 >> 2, wid2 & 3, lane2 & 15, lane2 >> 4);
  }
#undef SA
#undef SB
}

DEV void tile_rows_out(bf16_t* __restrict__ out0, const size_t ld, const int tid) {
#pragma unroll
  for (int i = 0; i < 16; ++i) {
    const int id = i * 512 + tid, r = id >> 5, pos = id & 31, c = pos ^ (r & 31);
    *(u32x4*)(out0 + (size_t)r * ld + 8 * c) = *(const u32x4*)(smem + r * 512 + pos * 16);
  }
}
DEV void tile_rows_in(const bf16_t* __restrict__ src0, const size_t ld, const int tid) {
#pragma unroll 1
  for (int io = 0; io < 4; ++io) {
    u32x4 v[4];
#pragma unroll
    for (int ii = 0; ii < 4; ++ii) {
      const int id = (io * 4 + ii) * 512 + tid, r = id >> 5, pos = id & 31, c = pos ^ (r & 31);
      v[ii] = __builtin_nontemporal_load((const u32x4*)(src0 + (size_t)r * ld + 8 * c));
    }
#pragma unroll
    for (int ii = 0; ii < 4; ++ii) {
      const int id = (io * 4 + ii) * 512 + tid, r = id >> 5, pos = id & 31;
      *(u32x4*)(smem + r * 512 + pos * 16) = v[ii];
    }
  }
}
DEV u32x2 tile_get4(const int r, const int col4) { return *(const u32x2*)(smem + r * 512 + ((((col4 >> 3)) ^ (r & 31)) * 16) + ((col4 & 4) << 1)); }
DEV void tile_put4(const int r, const int col4, const u32x2 v) {
  *(u32x2*)(smem + r * 512 + ((((col4 >> 3)) ^ (r & 31)) * 16) + ((col4 & 4) << 1)) = v;
}
struct EpiP1 {
  int mode;
  bf16_t* out; int ld; int segstart; float scale; const float* bmat; bf16_t* keT;
  DEV void operator()(f32x4 (&acc)[2][2][4][2], int brow, int bcol, int wr, int wc, int fr, int fq) const {
#pragma unroll
    for (int ai = 0; ai < 2; ++ai)
#pragma unroll
      for (int m = 0; m < 4; ++m) {
        const int rl = ai * 128 + wr * 64 + m * 16 + fr, tok = brow + rl;
#pragma unroll
        for (int bj = 0; bj < 2; ++bj)
#pragma unroll
          for (int n = 0; n < 2; ++n) {
            const int cl = bj * 128 + wc * 32 + n * 16 + fq * 4, lc = bcol - segstart + cl;
            f32x4 v = acc[ai][bj][m][n];
            if (mode == 0) {
              tile_put4(rl, cl, pk4(v * scale));
            } else if (mode == 1) {
              for (int j = 0; j < 4; ++j) v[j] = v[j] * fsigmoid(v[j]);
              tile_put4(rl, cl, pk4(v));
            } else if (mode == 2) {
              for (int j = 0; j < 4; ++j) v[j] = fsigmoid(v[j]);
              tile_put4(rl, cl, pk4(v));
            } else {
              const f32x4 b4 = *(const f32x4*)(bmat + (size_t)tok * 1024 + lc);
              const int pcl = (cl & ~15) + 4 * sig4((cl >> 2) & 3);
              if (mode == 3) {
                for (int j = 0; j < 4; ++j) v[j] = v[j] * scale * __expf(b4[j]);
                tile_put4(rl, pcl, pk4(v));
              } else {
                const f32x4 bl = *(const f32x4*)(bmat + (size_t)(tok | 63) * 1024 + lc);
                f32x4 kd, ke;
                for (int j = 0; j < 4; ++j) { kd[j] = v[j] * __expf(-b4[j]); ke[j] = v[j] * __expf(bl[j] - b4[j]); }
                tile_put4(rl, pcl, pk4(kd));
                (void)ke;
              }
            }
          }
      }
    __syncthreads();
    tile_rows_out(out + (size_t)brow * ld + (bcol - segstart), (size_t)ld, (wr * 4 + wc) * 64 + fq * 16 + fr);
    if (mode == 4) {
      __syncthreads();
#pragma unroll
      for (int ai = 0; ai < 2; ++ai)
#pragma unroll
        for (int m = 0; m < 4; ++m) {
          const int rl = ai * 128 + wr * 64 + m * 16 + fr, tok = brow + rl;
          const int tposl = (rl & ~15) + sig16(rl & 15);
#pragma unroll
          for (int bj = 0; bj < 2; ++bj)
#pragma unroll
            for (int n = 0; n < 2; ++n) {
              const int cl = bj * 128 + wc * 32 + n * 16 + fq * 4, lc = bcol - segstart + cl;
              const f32x4 v = acc[ai][bj][m][n];
              const f32x4 b4 = *(const f32x4*)(bmat + (size_t)tok * 1024 + lc);
              const f32x4 bl = *(const f32x4*)(bmat + (size_t)(tok | 63) * 1024 + lc);
              const u32x2 kk = pk4((f32x4){v[0] * __expf(bl[0] - b4[0]), v[1] * __expf(bl[1] - b4[1]), v[2] * __expf(bl[2] - b4[2]), v[3] * __expf(bl[3] - b4[3])});
#pragma unroll
              for (int j = 0; j < 4; ++j) {
                const int row = cl + j;
                const unsigned short val = (unsigned short)((j & 1) ? (kk[j >> 1] >> 16) : (kk[j >> 1] & 0xffff));
                *(unsigned short*)(smem + row * 512 + (((tposl >> 3) ^ (row & 31)) * 16) + (tposl & 7) * 2) = val;
              }
            }
        }
      __syncthreads();
      const int bt = brow >> 11, tl0 = brow & 2047, hd = (bcol - segstart) >> 8;
      tile_rows_out(keT + ((size_t)((bt * 4 + hd) * 256)) * 2048 + tl0, 2048, (wr * 4 + wc) * 64 + fq * 16 + fr);
    }
  }
};
struct EpiVT {
  bf16_t* out; int nch; int tshift; int segstart;
  DEV void operator()(f32x4 (&acc)[2][2][4][2], int brow, int bcol, int wr, int wc, int fr, int fq) const {
    const int T = 1 << tshift;
#pragma unroll
    for (int ai = 0; ai < 2; ++ai)
#pragma unroll
      for (int m = 0; m < 4; ++m) {
        const int tposl = ai * 128 + wr * 64 + m * 16 + 4 * sig4(fq);
#pragma unroll
        for (int bj = 0; bj < 2; ++bj)
#pragma unroll
          for (int n = 0; n < 2; ++n) tile_put4(bj * 128 + wc * 32 + n * 16 + fr, tposl, pk4(acc[ai][bj][m][n]));
      }
    __syncthreads();
    const int bt = brow >> tshift, tl0 = brow & (T - 1);
    tile_rows_out(out + ((size_t)(bt * nch + (bcol - segstart)) << tshift) + tl0, (size_t)T, (wr * 4 + wc) * 64 + fq * 16 + fr);
  }
};
struct EpiMerge {
  int step; int gidx; const bf16_t* gates; float* mg; bf16_t* mbf;
  DEV void operator()(f32x4 (&acc)[2][2][4][2], int brow, int bcol, int wr, int wc, int fr, int fq) const {
    const int tid = (wr * 4 + wc) * 64 + fq * 16 + fr;
    u32x2* sp = (u32x2*)mg + ((size_t)((brow >> 8) * 8 + (bcol >> 8)) * 32) * 512 + tid;
    tile_rows_in(gates + (size_t)brow * 6144 + gidx * 2048 + bcol, 6144, tid);
    __syncthreads();
#pragma unroll
    for (int ai = 0; ai < 2; ++ai)
#pragma unroll
      for (int m = 0; m < 4; ++m) {
        const int rl = ai * 128 + wr * 64 + m * 16 + fr, tok = brow + rl;
#pragma unroll
        for (int bj = 0; bj < 2; ++bj)
#pragma unroll
          for (int n = 0; n < 2; ++n) {
            const int cl = bj * 128 + wc * 32 + n * 16 + fq * 4, col = bcol + cl;
            const int f = ((ai * 4 + m) * 2 + bj) * 2 + n;
            const f32x4 g = unpk4(tile_get4(rl, cl));
            f32x4 v = acc[ai][bj][m][n] * g;
            if (step == 0) sp[(size_t)f * 512] = pk4(v);
            else if (step == 1) sp[(size_t)f * 512] = pk4(unpk4(sp[(size_t)f * 512]) + v);
            else tile_put4(rl, cl, pk4(unpk4(sp[(size_t)f * 512]) + v));
          }
      }
    if (step == 2) {
      __syncthreads();
      tile_rows_out(mbf + (size_t)brow * 2048 + bcol, 2048, tid);
    }
  }
};
struct EpiOut {
  bf16_t* y; float* part;
  DEV void operator()(f32x4 (&acc)[2][2][4][2], int brow, int bcol, int wr, int wc, int fr, int fq) const {
    const int tid = (wr * 4 + wc) * 64 + fq * 16 + fr;
#pragma unroll
    for (int ai = 0; ai < 2; ++ai)
#pragma unroll
      for (int m = 0; m < 4; ++m) {
        const int rl = ai * 128 + wr * 64 + m * 16 + fr, tok = brow + rl;
        float ss = 0.f;
#pragma unroll
        for (int bj = 0; bj < 2; ++bj)
#pragma unroll
          for (int n = 0; n < 2; ++n) {
            const int cl = bj * 128 + wc * 32 + n * 16 + fq * 4;
            const f32x4 v = acc[ai][bj][m][n];
            tile_put4(rl, cl, pk4(v));
            ss += v[0] * v[0] + v[1] * v[1] + v[2] * v[2] + v[3] * v[3];
          }
        ss += __shfl_xor(ss, 16); ss += __shfl_xor(ss, 32);
        if (fq == 0) part[(size_t)((bcol >> 8) * 4 + wc) * NTOK + tok] = ss;
      }
    __syncthreads();
    tile_rows_out(y + (size_t)brow * 2048 + bcol, 2048, tid);
  }
};

DEV void norm_rows64(const float* __restrict__ src, const float* __restrict__ g, bf16_t* __restrict__ dst, int r0) {
  const int tidx = otid();
  const int wave = tidx >> 6, lane = tidx & 63;
  for (int rr = 0; rr < 8; rr += 2) {
    const int row = r0 + wave * 8 + rr;
    const f32x4* xr = (const f32x4*)(src + (size_t)row * DM);
    f32x4 v[2][8]; float ss0 = 0.f, ss1 = 0.f;
#pragma unroll
    for (int i = 0; i < 8; ++i) { v[0][i] = __builtin_nontemporal_load(xr + lane + 64 * i); v[1][i] = __builtin_nontemporal_load(xr + 512 + lane + 64 * i); }
#pragma unroll
    for (int i = 0; i < 8; ++i) {
      ss0 += v[0][i][0] * v[0][i][0] + v[0][i][1] * v[0][i][1] + v[0][i][2] * v[0][i][2] + v[0][i][3] * v[0][i][3];
      ss1 += v[1][i][0] * v[1][i][0] + v[1][i][1] * v[1][i][1] + v[1][i][2] * v[1][i][2] + v[1][i][3] * v[1][i][3];
    }
    ss0 = wave_sum(ss0); ss1 = wave_sum(ss1);
    const float rs[2] = {rsqrtf(ss0 * (1.f / DM) + 1e-6f), rsqrtf(ss1 * (1.f / DM) + 1e-6f)};
#pragma unroll
    for (int i = 0; i < 8; ++i) {
      const f32x4 g4 = ((const f32x4*)g)[lane + 64 * i];
#pragma unroll
      for (int r = 0; r < 2; ++r) *(u32x2*)(dst + (size_t)(row + r) * DM + 4 * (lane + 64 * i)) = pk4(v[r][i] * rs[r] * g4);
    }
  }
}

DEV void p0_chunk(const Params& p, int item) {
  const int tid = otid(), wave = tid >> 6, lane = tid & 63;
  const int r0 = item * 64;
  bf16_t* h = (bf16_t*)(p.ws + OFF_H);
  norm_rows64(p.x, p.g_pre, h, r0);
  __syncthreads();
  float* gaL = (float*)smem;
  {
    const int row = lane & 15, kg = lane >> 4, tg = wave & 3, kh = wave >> 2;
    const bf16_t* ap = h + (size_t)(r0 + tg * 16 + row) * DM + 8 * kg + 1024 * kh;
    const float* wp = p.w_in + (size_t)(8 * kg + 1024 * kh) * 22544 + 6144 + row;
    f32x4 acc = {0.f, 0.f, 0.f, 0.f};
#pragma unroll 8
    for (int s = 0; s < 32; ++s) {
      const bf16x8 a = ld16(ap + 32 * s);
      float w[8];
#pragma unroll
      for (int e = 0; e < 8; ++e) w[e] = wp[(size_t)(32 * s + e) * 22544];
      u32x4 bw = {pk_bf16(w[0], w[1]), pk_bf16(w[2], w[3]), pk_bf16(w[4], w[5]), pk_bf16(w[6], w[7])};
      acc = __builtin_amdgcn_mfma_f32_16x16x32_bf16(a, __builtin_bit_cast(bf16x8, bw), acc, 0, 0, 0);
    }
#pragma unroll
    for (int j = 0; j < 4; ++j) gaL[kh * 1024 + (tg * 16 + kg * 4 + j) * 16 + row] = acc[j];
  }
  __syncthreads();
  float* bmat = (float*)(p.ws + OFF_B);
  float* eb = (float*)(p.ws + OFF_EB);
  float w2c[2][16], bias[2], run[2] = {0.f, 0.f};
#pragma unroll
  for (int k = 0; k < 2; ++k) {
    const int c = tid + 512 * k;
    bias[k] = p.a_b[c];
#pragma unroll
    for (int r = 0; r < 16; ++r) w2c[k][r] = p.a_w2[r * 1024 + c];
  }
  for (int tok = 0; tok < 64; ++tok) {
    float g[16];
#pragma unroll
    for (int q = 0; q < 4; ++q) { const f32x4 t4 = *(const f32x4*)(gaL + tok * 16 + 4 * q) + *(const f32x4*)(gaL + 1024 + tok * 16 + 4 * q); g[4 * q] = t4[0]; g[4 * q + 1] = t4[1]; g[4 * q + 2] = t4[2]; g[4 * q + 3] = t4[3]; }
#pragma unroll
    for (int k = 0; k < 2; ++k) {
      float xv = bias[k];
#pragma unroll
      for (int r = 0; r < 16; ++r) xv += g[r] * w2c[k][r];
      run[k] += logsigmoid(xv) * (1.f / 16.f);
      bmat[(size_t)(r0 + tok) * 1024 + tid + 512 * k] = run[k];
    }
  }
#pragma unroll
  for (int k = 0; k < 2; ++k) eb[(size_t)item * 1024 + tid + 512 * k] = __expf(run[k]);
  __syncthreads();
}

DEV void p0_transpose8(const Params& p, int nt2, int kq) {
  const float* src; int ld, scol; bf16_t* dst;
  const int nt = nt2 * 2;
  if (nt < 352) { const int c = nt * 64; src = p.w_in; ld = 22544; scol = c + (c >= 6144 ? 16 : 0); dst = (bf16_t*)(p.ws + OFF_WT_IN) + (size_t)c * 2048; }
  else if (nt < 416) { const int c = (nt - 352) * 64; src = p.w_mkv; ld = 4096; scol = c; dst = (bf16_t*)(p.ws + OFF_WT_MKV) + (size_t)c * 2048; }
  else if (nt < 448) { const int c = (nt - 416) * 64; src = p.w_pg; ld = 2048; scol = c; dst = (bf16_t*)(p.ws + OFF_WT_PG) + (size_t)c * 2048; }
  else if (nt < 480) { const int c = (nt - 448) * 64; src = p.w_ps; ld = 2048; scol = c; dst = (bf16_t*)(p.ws + OFF_WT_PS) + (size_t)c * 2048; }
  else if (nt < 512) { const int c = (nt - 480) * 64; src = p.w_pm; ld = 2048; scol = c; dst = (bf16_t*)(p.ws + OFF_WT_PM) + (size_t)c * 2048; }
  else { const int c = (nt - 512) * 64; src = p.w_out; ld = 2048; scol = c; dst = (bf16_t*)(p.ws + OFF_WT_OUT) + (size_t)c * 2048; }
  const int t = otid();
  const int k0 = kq * 256;
  unsigned* T32 = (unsigned*)smem;
  {
    const int r2 = t >> 5, c4 = t & 31;
    const float* sp = src + (size_t)(k0 + 2 * r2) * ld + scol + 4 * c4;
    f32x4 v0[8], v1[8];
#pragma unroll
    for (int kk = 0; kk < 8; ++kk) {
      v0[kk] = __builtin_nontemporal_load((const f32x4*)(sp + (size_t)(kk * 32) * ld)); v1[kk] = __builtin_nontemporal_load((const f32x4*)(sp + (size_t)(kk * 32 + 1) * ld)); }
#pragma unroll
    for (int kk = 0; kk < 8; ++kk)
#pragma unroll
      for (int j = 0; j < 4; ++j) T32[(kk * 128 + 4 * c4 + j) * 17 + r2] = pk_bf16(v0[kk][j], v1[kk][j]);
  }
  __syncthreads();
  {
    const int n = t >> 2, g = t & 3;
#pragma unroll
    for (int i = 0; i < 8; ++i) {
      const int ch = g + 4 * i, kk = ch >> 2, w4 = (ch & 3) * 4;
      const unsigned* tp = T32 + (kk * 128 + n) * 17 + w4;
      const u32x4 w = {tp[0], tp[1], tp[2], tp[3]};
      *(u32x4*)(dst + (size_t)n * 2048 + k0 + 8 * ch) = w;
    }
  }
  __syncthreads();
}

DEV void phase0(const Params& p) {
  const int tidx = otid();
  unsigned* ctr = (unsigned*)(p.ws + OFF_MISC + 512);
  volatile int* slot = (volatile int*)(smem + 131072 + 2048);
  const int total = 128 + 16 + 272 * 8;
  bool first = true;
  while (true) {
    __syncthreads();
    if (tidx == 0) *slot = first ? (int)blockIdx.x : (int)(gridDim.x + atomicAdd(ctr, 1u));
    first = false;
    __syncthreads();
    const int it = __builtin_amdgcn_readfirstlane(*slot);
    if (it >= total) break;
    if (it < 128) p0_chunk(p, it);
    else if (it < 144) { norm_rows64(p.mem, p.g_mem, (bf16_t*)(p.ws + OFF_MEMH), (it - 128) * 64); }
    else { const int tt = it - 144; p0_transpose8(p, tt >> 3, tt & 7); }
  }
}

#define MKV_IN_P2 1
DEV void phase1(const Params& p, const int base_item) {
  const int nwg = MKV_IN_P2 ? 2816 : 2816 + 64;
  const int Lbeg = base_item >= 0 ? base_item : (int)blockIdx.x, Lend = base_item >= 0 ? base_item + 1 : nwg;
#pragma unroll 1
  for (int L = Lbeg; L < Lend; L += gridDim.x) {
    const bf16_t* a; const bf16_t* w; int brow, bcol; bool vt;
    EpiVT ev; EpiP1 e;
    e.bmat = (const float*)(p.ws + OFF_B); e.keT = (bf16_t*)(p.ws + OFF_KET); e.ld = 2048; e.scale = 1.f; e.mode = 0; e.out = nullptr; e.segstart = 0;
    ev.out = nullptr; ev.nch = 2048; ev.tshift = 11; ev.segstart = 0;
    if (L < 2816) {
      const int xcd = L & 7, off = L >> 3, wgid = xcd * 352 + off;
      const int nig = 8 * 88, gid = wgid / nig, pm = gid * 8 + (wgid % nig) % 8, pn = (wgid % nig) / 8;
      brow = pm * 256; bcol = pn * 256;
      a = (const bf16_t*)(p.ws + OFF_H); w = (const bf16_t*)(p.ws + OFF_WT_IN);
      vt = (bcol >= 2048 && bcol < 4096) || (bcol >= 10240 && bcol < 12288);
      if (vt) {
        if (bcol < 4096) { ev.out = (bf16_t*)(p.ws + OFF_GVT); ev.segstart = 2048; } else { ev.out = (bf16_t*)(p.ws + OFF_SVT); ev.segstart = 10240; }
      } else {
        if (bcol < 1024) { e.mode = 3; e.out = (bf16_t*)(p.ws + OFF_QP); e.segstart = 0; e.scale = 1.f / 16.f; e.ld = 1024; }
        else if (bcol < 2048) { e.mode = 4; e.out = (bf16_t*)(p.ws + OFF_KDP); e.segstart = 1024; e.ld = 1024; }
        else if (bcol < 6144) { e.mode = 1; e.out = (bf16_t*)(p.ws + OFF_SGG); e.segstart = 4096; }
        else if (bcol < 8192) { e.mode = 0; e.out = (bf16_t*)(p.ws + OFF_SQ); e.segstart = 6144; e.scale = 0.08838834764831845f * 1.4426950408889634f; }
        else if (bcol < 10240) { e.mode = 0; e.out = (bf16_t*)(p.ws + OFF_SK); e.segstart = 8192; }
        else if (bcol < 14336) { e.mode = 1; e.out = (bf16_t*)(p.ws + OFF_SSG); e.segstart = 12288; }
        else if (bcol < 16384) { e.mode = 0; e.out = (bf16_t*)(p.ws + OFF_MQ); e.segstart = 14336; e.scale = 0.04419417382415922f; }
        else { e.mode = 2; e.out = (bf16_t*)(p.ws + OFF_GATES); e.segstart = 16384; e.ld = 6144; }
      }
    } else {
      const int l = L - 2816, pm = l & 3, pn = l >> 2;
      brow = pm * 256; bcol = pn * 256;
      a = (const bf16_t*)(p.ws + OFF_MEMH); w = (const bf16_t*)(p.ws + OFF_WT_MKV);
      vt = bcol >= 2048;
      if (vt) { ev.out = (bf16_t*)(p.ws + OFF_MVT); ev.tshift = 8; ev.segstart = 2048; }
      else { e.mode = 0; e.out = (bf16_t*)(p.ws + OFF_MK); }
    }
    if (vt) gemm_tile<false>(a, w, 2048, brow, bcol, ev);
    else gemm_tile<true>(a, w, 2048, brow, bcol, e);
  }
}

DEV void panel_publish(unsigned* cnt, const int tidx) {
  asm volatile("s_waitcnt vmcnt(0)" ::: "memory");
  __syncthreads();
  if (tidx == 0) {
    __builtin_amdgcn_fence(__ATOMIC_RELEASE, "agent");
    asm volatile("s_waitcnt vmcnt(0)" ::: "memory");
    __hip_atomic_fetch_add(cnt, 1u, __ATOMIC_RELAXED, __HIP_MEMORY_SCOPE_AGENT);
  }
}
DEV void panel_wait(unsigned* cnt, const unsigned need, const int tidx) {
  if (tidx == 0) {
    while (__hip_atomic_load(cnt, __ATOMIC_RELAXED, __HIP_MEMORY_SCOPE_AGENT) < need) __builtin_amdgcn_s_sleep(2);
    __builtin_amdgcn_fence(__ATOMIC_ACQUIRE, "agent");
    asm volatile("s_waitcnt vmcnt(0)" ::: "memory");
  }
  __syncthreads();
}
#define GLDS16(src_, dst_) __builtin_amdgcn_global_load_lds((const unsigned*)(src_), (unsigned*)(dst_), 16, 0, 0)

DEV void gla_block(const Params& p, int g) {
  const int tidx = otid();
  const int wave = __builtin_amdgcn_readfirstlane(tidx >> 6), lane = tidx & 63, l31 = lane & 31, hh = lane >> 5;
  const int bh = g >> 2, b = bh >> 2, h = bh & 3, dkh = wave >> 2, vs = (g & 3) * 4 + (wave & 3);
  const bf16_t* Qp = (const bf16_t*)(p.ws + OFF_QP);
  const bf16_t* KeT = (const bf16_t*)(p.ws + OFF_KET);
  const bf16_t* gvT = (const bf16_t*)(p.ws + OFF_GVT);
  const float* eb = (const float*)(p.ws + OFF_EB);
  f32x16 S[4];
#pragma unroll
  for (int t = 0; t < 4; ++t) for (int gg = 0; gg < 16; ++gg) S[t][gg] = 0.f;
  const bf16_t* vrow = gvT + ((size_t)(b * 2048 + h * 512 + vs * 32 + l31)) * 2048 + 8 * hh;
  const bf16_t* qsrc; const bf16_t* ksrc;
  {
    const int rq = lane >> 5, pq = lane & 31;
    const int rk = lane >> 3, pk = lane & 7;
    qsrc = Qp + ((size_t)b * 2048 + rq) * 1024 + h * 256;
    ksrc = KeT + ((size_t)((b * 4 + h) * 256 + rk)) * 2048;
    (void)pq; (void)pk;
  }
#define GLA_DMA(c_, buf_) do { const int tok0_ = (c_) * 64; \
    _Pragma("unroll") for (int i_ = 0; i_ < 8; ++i_) { const int k_ = wave * 8 + i_; \
      if (k_ < 32) { const int r_ = 2 * k_ + (lane >> 5); \
        GLDS16(qsrc + (size_t)(tok0_ + 2 * k_) * 1024 + (((lane & 31) ^ (r_ & 31)) * 8), smem + (buf_) * 65536 + k_ * 1024 + lane * 16); } \
      else { const int kk_ = k_ - 32, r_ = 8 * kk_ + (lane >> 3); \
        GLDS16(ksrc + (size_t)(8 * kk_) * 2048 + tok0_ + (((lane & 7) ^ ((r_ >> 1) & 7)) * 8), smem + (buf_) * 65536 + 32768 + kk_ * 1024 + lane * 16); } } } while (0)
#define GLA_EB(c_, buf_) do { if (wave == 0) GLDS16(eb + (size_t)(b * 32 + (c_)) * 1024 + h * 256 + lane * 4, smem + 131072 + (buf_) * 1024 + lane * 16); } while (0)
  const int Q0 = l31 * 512 + (((16 * dkh + hh) ^ l31) * 16);
  const int K0 = 32768 + (128 * dkh + l31) * 128 + ((hh ^ ((l31 >> 1) & 7)) * 16);
  asm volatile("s_waitcnt vmcnt(0)" ::: "memory");
  __syncthreads();
  GLA_DMA(0, 0); GLA_EB(0, 0);
  bf16x8 vf[4], vfn[4];
#pragma unroll
  for (int s4 = 0; s4 < 4; ++s4) { vf[s4] = ld16(vrow + 16 * s4); vfn[s4] = vf[s4]; }
  asm volatile("s_waitcnt vmcnt(0)" ::: "memory");
  __syncthreads();
#pragma unroll 1
  for (int c = 0; c < 32; ++c) {
    const int tok0 = c * 64, buf = c & 1;
    const size_t grow = (size_t)b * 2048 + tok0;
    if (c + 1 < 32) {
      GLA_DMA(c + 1, buf ^ 1); GLA_EB(c + 1, buf ^ 1);
#pragma unroll
      for (int s4 = 0; s4 < 4; ++s4) vfn[s4] = ld16(vrow + tok0 + 64 + 16 * s4);
    }
    const char* lq = smem + buf * 65536;
    int q0v = Q0, k0v = K0;
    asm volatile("" : "+v"(q0v), "+v"(k0v));
    f32x16 o0, o1;
    for (int gg = 0; gg < 16; ++gg) { o0[gg] = 0.f; o1[gg] = 0.f; }
#pragma unroll
    for (int th = 0; th < 2; ++th) {
      bf16x8 qa[2][2], qb_[2][2];
#pragma unroll
      for (int t = 0; t < 2; ++t)
#pragma unroll
        for (int s = 0; s < 2; ++s) { qa[t][s] = *(const bf16x8*)(lq + (q0v ^ (64 * (2 * th + t) + 32 * s))); qb_[t][s] = *(const bf16x8*)(lq + (q0v ^ (64 * (2 * th + t) + 32 * s)) + 32 * 512); }
      __builtin_amdgcn_sched_barrier(0);
#pragma unroll
      for (int t = 0; t < 2; ++t) {
        const bf16x8 s0 = cvt8<0>(S[2 * th + t]), s1 = cvt8<1>(S[2 * th + t]);
        o0 = mfma32(s0, qa[t][0], o0); o1 = mfma32(s0, qb_[t][0], o1);
        o0 = mfma32(s1, qa[t][1], o0); o1 = mfma32(s1, qb_[t][1], o1);
      }
      __builtin_amdgcn_sched_barrier(0);
    }
    {
      const float* ebl = (const float*)(smem + 131072 + buf * 1024) + dkh * 128 + 4 * hh;
#pragma unroll
      for (int t = 0; t < 4; ++t)
#pragma unroll
        for (int q = 0; q < 4; ++q) { const f32x4 e4 = *(const f32x4*)(ebl + 32 * t + 8 * q); for (int j = 0; j < 4; ++j) S[t][4 * q + j] *= e4[j]; }
#pragma unroll
      for (int sh = 0; sh < 2; ++sh) {
        bf16x8 kf[4][2];
#pragma unroll
        for (int t = 0; t < 4; ++t)
#pragma unroll
          for (int s = 0; s < 2; ++s) kf[t][s] = *(const bf16x8*)(lq + (k0v ^ (32 * (2 * sh + s))) + t * 4096);
        __builtin_amdgcn_sched_barrier(0);
#pragma unroll
        for (int s = 0; s < 2; ++s)
#pragma unroll
          for (int t = 0; t < 4; ++t) S[t] = mfma32(kf[t][s], vf[2 * sh + s], S[t]);
        __builtin_amdgcn_sched_barrier(0);
      }
    }
#pragma unroll
    for (int s4 = 0; s4 < 4; ++s4) vf[s4] = vfn[s4];
    u32x2* xch = (u32x2*)(smem + 135168) + (wave & 3) * 512 + lane;
    __syncthreads();
    if (dkh == 1) {
#pragma unroll
      for (int q = 0; q < 4; ++q) {
        const f32x4 a0 = {o0[4 * q], o0[4 * q + 1], o0[4 * q + 2], o0[4 * q + 3]}, a1 = {o1[4 * q], o1[4 * q + 1], o1[4 * q + 2], o1[4 * q + 3]};
        xch[q * 64] = pk4(a0); xch[(4 + q) * 64] = pk4(a1);
      }
    }
    asm volatile("s_waitcnt vmcnt(0)" ::: "memory");
    __syncthreads();
    if (dkh == 0) {
      u32x2* o_ = (u32x2*)(p.ws + OFF_OP0) + ((((size_t)((b * 32 + c) * 4 + h) * 16 + vs) * 2) * 4) * 64 + lane;
#pragma unroll
      for (int q = 0; q < 4; ++q) {
        const f32x4 a0 = {o0[4 * q], o0[4 * q + 1], o0[4 * q + 2], o0[4 * q + 3]}, a1 = {o1[4 * q], o1[4 * q + 1], o1[4 * q + 2], o1[4 * q + 3]};
        o_[q * 64] = pk4(a0 + unpk4(xch[q * 64])); o_[(4 + q) * 64] = pk4(a1 + unpk4(xch[(4 + q) * 64]));
      }
    }
  }
  asm volatile("s_waitcnt vmcnt(0)" ::: "memory");
  __syncthreads();
#undef GLA_EB
#undef GLA_DMA
  panel_publish((unsigned*)(p.ws + OFF_MISC + 2048 + 768) + bh, tidx);
}

template <bool DIAG>
DEV void sb_tile(const char* lk, const char* lv, const int ko0, const int vo0, const bf16x8 (&qf)[8], f32x16 (&O)[4], float& accp,
                 const int l31, const int hh) {
  f32x16 z;
  for (int g = 0; g < 16; ++g) z[g] = 0.f;
  {
    bf16x8 kf[8];
#pragma unroll
    for (int s = 0; s < 8; ++s) kf[s] = *(const bf16x8*)(lk + (ko0 ^ (32 * s)));
    __builtin_amdgcn_sched_barrier(0);
#pragma unroll
    for (int s = 0; s < 8; ++s) z = mfma32(kf[s], qf[s], z);
  }
  bf16x8 vf[4][2];
#pragma unroll
  for (int d = 0; d < 4; ++d) { vf[d][0] = *(const bf16x8*)(lv + d * 4096 + vo0); vf[d][1] = *(const bf16x8*)(lv + d * 4096 + (vo0 ^ 32)); }
  __builtin_amdgcn_sched_barrier(0);
  float be[16], om[16];
#pragma unroll
  for (int g = 0; g < 16; ++g) {
    const float e = __builtin_amdgcn_exp2f(fminf(-z[g], 120.f));
    be[g] = __builtin_amdgcn_rcpf(1.f + e);
    om[g] = e * be[g];
    if (DIAG) { const int kl = (g & 3) + 8 * (g >> 2) + 4 * hh; if (kl >= l31) { be[g] = 0.f; om[g] = 1.f; } }
  }
  float gp[4], pp[4], tot[4];
#pragma unroll
  for (int q = 0; q < 4; ++q) { gp[q] = (om[4 * q] * om[4 * q + 1]) * (om[4 * q + 2] * om[4 * q + 3]); pp[q] = __shfl_xor(gp[q], 32); tot[q] = gp[q] * pp[q]; }
  float suf[4];
  suf[3] = accp; suf[2] = suf[3] * tot[3]; suf[1] = suf[2] * tot[2]; suf[0] = suf[1] * tot[1];
  accp = suf[0] * tot[0];
  f32x16 w;
#pragma unroll
  for (int q = 0; q < 4; ++q) {
    float a = suf[q] * (hh == 0 ? pp[q] : 1.f);
    w[4 * q + 3] = be[4 * q + 3] * a; a *= om[4 * q + 3];
    w[4 * q + 2] = be[4 * q + 2] * a; a *= om[4 * q + 2];
    w[4 * q + 1] = be[4 * q + 1] * a; a *= om[4 * q + 1];
    w[4 * q + 0] = be[4 * q + 0] * a;
  }
  const bf16x8 w0 = cvt8<0>(w), w1 = cvt8<1>(w);
#pragma unroll
  for (int d = 0; d < 4; ++d) { O[d] = mfma32(vf[d][0], w0, O[d]); O[d] = mfma32(vf[d][1], w1, O[d]); }
}

DEV void sb_block(const Params& p, int item) {
  const int tidx = otid();
  const int wave = __builtin_amdgcn_readfirstlane(tidx >> 6), lane = tidx & 63, l31 = lane & 31, hh = lane >> 5;
  const int qb = 7 - (item >> 6), bh = item & 63, b = bh >> 4, h = bh & 15;
  const int qt = 8 * qb + wave;
  const bf16_t* sq = (const bf16_t*)(p.ws + OFF_SQ);
  const bf16_t* sk = (const bf16_t*)(p.ws + OFF_SK);
  const bf16_t* svT = (const bf16_t*)(p.ws + OFF_SVT);
  const bf16_t* ssg = (const bf16_t*)(p.ws + OFF_SSG);
  bf16_t* ob = (bf16_t*)(p.ws + OFF_OB);
  const size_t row0 = (size_t)b * 2048;
  bf16x8 qf[8];
  {
    const bf16_t* qp = sq + (row0 + qt * 32 + l31) * 2048 + h * 128 + 8 * hh;
#pragma unroll
    for (int s = 0; s < 8; ++s) qf[s] = ld16(qp + 16 * s);
  }
  f32x16 O[4];
#pragma unroll
  for (int d = 0; d < 4; ++d) for (int g = 0; g < 16; ++g) O[d][g] = 0.f;
  float accp = 1.f;
  const bf16_t* ksrc = sk + (row0 + (lane >> 4)) * 2048 + h * 128;
  const bf16_t* vsrc = svT + ((size_t)(b * 2048 + h * 128 + (lane >> 3))) * 2048;
#define SB_DMA(j_, buf_) do { \
    _Pragma("unroll") for (int i_ = 0; i_ < 4; ++i_) { const int k_ = wave * 4 + i_; \
      if (k_ < 16) { const int r_ = 4 * k_ + (lane >> 4); \
        GLDS16(ksrc + (size_t)(64 * (j_) + 4 * k_) * 2048 + (((lane & 15) ^ (r_ & 15)) * 8), smem + (buf_) * 32768 + k_ * 1024 + lane * 16); } \
      else { const int kk_ = k_ - 16, r_ = 8 * kk_ + (lane >> 3); \
        GLDS16(vsrc + (size_t)(8 * kk_) * 2048 + 64 * (j_) + (((lane & 7) ^ ((r_ >> 1) & 7)) * 8), smem + (buf_) * 32768 + 16384 + kk_ * 1024 + lane * 16); } } } while (0)
  const int KO0 = l31 * 256 + ((hh ^ (l31 & 15)) * 16);
  const int VO0 = 16384 + l31 * 128 + ((hh ^ ((l31 >> 1) & 7)) * 16);
  const int nsteps = 4 * qb + 4;
  asm volatile("s_waitcnt vmcnt(0)" ::: "memory");
  __syncthreads();
  { const int j0 = nsteps - 1; SB_DMA(j0, 0); SB_DMA((j0 > 0 ? j0 - 1 : 0), 1); SB_DMA((j0 > 1 ? j0 - 2 : 0), 2); }
#pragma unroll 1
  for (int n = 0; n < nsteps; ++n) {
    const int j = nsteps - 1 - n, buf = n & 3;
    asm volatile("s_waitcnt vmcnt(8)" ::: "memory");
    __builtin_amdgcn_s_barrier();
    asm volatile("" ::: "memory");
    { const int jn = j > 3 ? j - 3 : 0; SB_DMA(jn, (n + 3) & 3); }
    const char* lb_ = smem + buf * 32768;
    int ko0 = KO0, vo0 = VO0;
    asm volatile("" : "+v"(ko0), "+v"(vo0));
    if (2 * j + 1 == qt) sb_tile<true>(lb_ + 32 * 256, lb_, ko0, vo0 ^ 64, qf, O, accp, l31, hh);
    else if (2 * j + 1 < qt) sb_tile<false>(lb_ + 32 * 256, lb_, ko0, vo0 ^ 64, qf, O, accp, l31, hh);
    if (2 * j == qt) sb_tile<true>(lb_, lb_, ko0, vo0, qf, O, accp, l31, hh);
    else if (2 * j < qt) sb_tile<false>(lb_, lb_, ko0, vo0, qf, O, accp, l31, hh);
    asm volatile("" ::: "memory");
  }
  asm volatile("s_waitcnt vmcnt(0)" ::: "memory");
#undef SB_DMA
  __syncthreads();
  {
    char* lw = smem + wave * 16384;
#pragma unroll
    for (int d = 0; d < 4; ++d)
#pragma unroll
      for (int q = 0; q < 4; ++q) {
        const f32x4 o = {O[d][4 * q], O[d][4 * q + 1], O[d][4 * q + 2], O[d][4 * q + 3]};
        *(f32x4*)(lw + l31 * 512 + (((8 * d + 2 * q + hh) ^ l31) * 16)) = o;
      }
    asm volatile("s_waitcnt lgkmcnt(0)" ::: "memory");
    const size_t tok0 = row0 + qt * 32;
    u32x2 gv[16];
#pragma unroll
    for (int i = 0; i < 16; ++i) { const int r = 2 * i + hh, c = l31 ^ r; gv[i] = __builtin_nontemporal_load((const u32x2*)(ssg + (tok0 + r) * 2048 + h * 128 + 4 * c)); }
#pragma unroll
    for (int i = 0; i < 16; ++i) {
      const int r = 2 * i + hh, c = l31 ^ r;
      const f32x4 o = *(const f32x4*)(lw + r * 512 + l31 * 16);
      *(u32x2*)(ob + (tok0 + r) * 2048 + h * 128 + 4 * c) = pk4(o * unpk4(gv[i]));
    }
  }
  panel_publish((unsigned*)(p.ws + OFF_MISC + 2048 + 896) + (b * 8 + qb), tidx);
  __syncthreads();
}

DEV void mem_block(const Params& p, int item) {
  const int tidx = otid();
  const int wave = __builtin_amdgcn_readfirstlane(tidx >> 6), lane = tidx & 63, l31 = lane & 31, hh = lane >> 5;
  const int h = item & 3, qblk = item >> 2, qt = qblk * 8 + wave, b = qblk >> 3;
  const size_t tok = (size_t)qt * 32 + l31;
  const bf16_t* qp = (const bf16_t*)(p.ws + OFF_MQ) + tok * 2048 + h * 512 + 8 * hh;
  const bf16_t* ksrc = (const bf16_t*)(p.ws + OFF_MK) + ((size_t)(b * 256 + (lane >> 3))) * 2048 + h * 512;
  const bf16_t* vsrc = (const bf16_t*)(p.ws + OFF_MVT) + ((size_t)(b * 2048 + h * 512 + (lane >> 5))) * 256;
  bf16_t* om = (bf16_t*)(p.ws + OFF_OM);
#define MEM_DMA(n_, buf_) do { \
    _Pragma("unroll") for (int i_ = 0; i_ < 4; ++i_) { const int k_ = wave * 4 + i_; \
      if ((n_) < 8) { const int r_ = 8 * k_ + (lane >> 3); \
        GLDS16(ksrc + (size_t)(8 * k_) * 2048 + 64 * (n_) + (((lane & 7) ^ ((r_ >> 1) & 7)) * 8), smem + (buf_) * 32768 + k_ * 1024 + lane * 16); } \
      else { const int r_ = 2 * k_ + (lane >> 5); \
        GLDS16(vsrc + (size_t)(64 * ((n_) - 8) + 2 * k_) * 256 + (((lane & 31) ^ (r_ & 31)) * 8), smem + (buf_) * 32768 + k_ * 1024 + lane * 16); } } } while (0)
  const int KF0 = l31 * 128 + ((hh ^ ((l31 >> 1) & 7)) * 16);
  f32x16 Sx[8];
#pragma unroll
  for (int t = 0; t < 8; ++t) for (int g = 0; g < 16; ++g) Sx[t][g] = 0.f;
  asm volatile("s_waitcnt vmcnt(0)" ::: "memory");
  __syncthreads();
  bf16x8 bq[3][4];
#pragma unroll
  for (int kq = 0; kq < 4; ++kq) bq[0][kq] = ld16(qp + 16 * kq);
  MEM_DMA(0, 0);
#pragma unroll
  for (int kq = 0; kq < 4; ++kq) bq[1][kq] = ld16(qp + 64 + 16 * kq);
  MEM_DMA(1, 1);
#pragma unroll
  for (int n = 0; n < 8; ++n) {
    const int buf = n % 3, nb = (n + 2) % 3;
    asm volatile("s_waitcnt vmcnt(8)" ::: "memory");
    __builtin_amdgcn_s_barrier();
    asm volatile("" ::: "memory");
    {
      const int nq = n + 2 < 8 ? n + 2 : 7;
#pragma unroll
      for (int kq = 0; kq < 4; ++kq) bq[nb][kq] = ld16(qp + 64 * nq + 16 * kq);
    }
    MEM_DMA(n + 2, nb);
    const char* lf = smem + buf * 32768;
    int kf0 = KF0;
    asm volatile("" : "+v"(kf0));
#pragma unroll
    for (int kq = 0; kq < 4; ++kq) {
      bf16x8 kf[8];
#pragma unroll
      for (int t = 0; t < 8; ++t) kf[t] = *(const bf16x8*)(lf + t * 4096 + (kf0 ^ (32 * kq)));
      __builtin_amdgcn_sched_barrier(0);
#pragma unroll
      for (int t = 0; t < 8; ++t) Sx[t] = mfma32(kf[t], bq[buf][kq], Sx[t]);
    }
    asm volatile("" ::: "memory");
  }
  int buf = 8 % 3;
  float mx = -1e30f;
#pragma unroll
  for (int t = 0; t < 8; ++t) for (int g = 0; g < 16; ++g) mx = fmaxf(mx, Sx[t][g]);
  mx = fmaxf(mx, __shfl_xor(mx, 32));
  float sum = 0.f;
#pragma unroll
  for (int t = 0; t < 8; ++t) for (int g = 0; g < 16; ++g) { const float e = __expf(Sx[t][g] - mx); Sx[t][g] = e; sum += e; }
  sum += __shfl_xor(sum, 32);
  const float inv = 1.f / sum;
  bf16x8 pf[8][2];
#pragma unroll
  for (int t = 0; t < 8; ++t) { pf[t][0] = cvt8<0>(Sx[t]); pf[t][1] = cvt8<1>(Sx[t]); }
  const int VF0 = l31 * 512 + ((hh ^ l31) * 16);
#pragma unroll 1
  for (int n = 8; n < 16; ++n) {
    if (n == 8) asm volatile("s_waitcnt vmcnt(4)" ::: "memory");
    else if (n == 9) asm volatile("s_waitcnt vmcnt(8)" ::: "memory");
    else asm volatile("s_waitcnt vmcnt(12)" ::: "memory");
    __builtin_amdgcn_s_barrier();
    asm volatile("" ::: "memory");
    const int nb = buf >= 1 ? buf - 1 : 2;
    { const int nn = n + 2 < 16 ? n + 2 : 15; MEM_DMA(nn, nb); }
    const char* lf = smem + buf * 32768;
    int vf0 = VF0;
    asm volatile("" : "+v"(vf0));
    char* lw = smem + 98304 + wave * 4096;
#pragma unroll
    for (int dd = 0; dd < 2; ++dd) {
      f32x16 o;
      for (int g = 0; g < 16; ++g) o[g] = 0.f;
#pragma unroll
      for (int t = 0; t < 8; ++t) { o = mfma32(*(const bf16x8*)(lf + dd * 16384 + (vf0 ^ (64 * t))), pf[t][0], o); o = mfma32(*(const bf16x8*)(lf + dd * 16384 + (vf0 ^ (64 * t + 32))), pf[t][1], o); }
#pragma unroll
      for (int q = 0; q < 4; ++q) {
        f32x4 v = {o[4 * q] * inv, o[4 * q + 1] * inv, o[4 * q + 2] * inv, o[4 * q + 3] * inv};
        *(u32x2*)(lw + l31 * 128 + (((4 * dd + q) ^ (l31 & 7)) * 16) + hh * 8) = pk4(v);
      }
    }
    asm volatile("s_waitcnt lgkmcnt(0)" ::: "memory");
#pragma unroll
    for (int i = 0; i < 4; ++i) {
      const int id = i * 64 + lane, r = id >> 3, pos = id & 7, c = pos ^ (r & 7);
      *(u32x4*)(om + ((size_t)qt * 32 + r) * 2048 + h * 512 + 64 * (n - 8) + 8 * c) = *(const u32x4*)(lw + r * 128 + pos * 16);
    }
    buf = buf == 2 ? 0 : buf + 1;
    asm volatile("" ::: "memory");
  }
#undef MEM_DMA
  panel_publish((unsigned*)(p.ws + OFF_MISC + 2048 + 896) + qblk, tidx);
  __syncthreads();
}

DEV void phase2(const Params& p, int rerun) {
  const int tidx = otid();
  const int parts = rerun ? PROBE_PART : 7;
  if (parts & 1) for (int g = blockIdx.x; g < 64; g += gridDim.x) gla_block(p, g);
  unsigned* ctr = (unsigned*)(p.ws + OFF_MISC + (rerun ? 256 : 0));
  volatile int* slot = (volatile int*)(smem + 131072 + 2048);
  unsigned* mkv_done = (unsigned*)(p.ws + OFF_MISC + 1024);
  const int nstatic = ((parts & 1) && gridDim.x > 64) ? (int)gridDim.x - 64 : ((parts & 1) ? 0 : (int)gridDim.x);
  bool first = ((parts & 1) ? (int)blockIdx.x >= 64 && nstatic > 0 : true);
  const int firstit = (parts & 1) ? (int)blockIdx.x - 64 : (int)blockIdx.x;
  while (true) {
    __syncthreads();
    if (tidx == 0) *slot = first ? firstit : (int)(nstatic + atomicAdd(ctr, 1u));
    first = false;
    __syncthreads();
    const int it = __builtin_amdgcn_readfirstlane(*slot);
    if (it >= 64 + 512 + 128) break;
    if (it < 64) {
      phase1(p, 2816 + it);
      __threadfence();
      __syncthreads();
      if (tidx == 0) atomicAdd(mkv_done, 1u);
    } else if (it < 64 + 320) { if (parts & 2) sb_block(p, it - 64); }
    else if (it >= 64 + 320 + 128) { if (parts & 2) sb_block(p, it - 64 - 128); }
    else {
      if (tidx == 0) {
        while (__hip_atomic_load(mkv_done, __ATOMIC_RELAXED, __HIP_MEMORY_SCOPE_AGENT) < 64u) __builtin_amdgcn_s_sleep(8);
        __builtin_amdgcn_fence(__ATOMIC_ACQUIRE, "agent");
      }
      __syncthreads();
      if (parts & 4) mem_block(p, it - 64 - 320);
    }
  }
}

DEV void phase25(const Params& p, const bool fuse) {
  const int tidx = otid();
  const int wave = __builtin_amdgcn_readfirstlane(tidx >> 6), lane = tidx & 63, l31 = lane & 31, hh = lane >> 5;
  const bf16_t* Qp = (const bf16_t*)(p.ws + OFF_QP);
  const bf16_t* Kd = (const bf16_t*)(p.ws + OFF_KDP);
  const bf16_t* gvT = (const bf16_t*)(p.ws + OFF_GVT);
  const bf16_t* sgg = (const bf16_t*)(p.ws + OFF_SGG);
  const float* op0 = (const float*)(p.ws + OFF_OP0);
  const float* op1 = (const float*)(p.ws + OFF_OP1);
  bf16_t* oa = (bf16_t*)(p.ws + OFF_OA);
  float* ssL = (float*)(smem + 131072 + 3072);
  unsigned* ctr25 = (unsigned*)(p.ws + OFF_MISC + 1280);
  volatile int* slot25 = (volatile int*)(smem + 131072 + 2048);
  int itn = blockIdx.x;
#pragma unroll 1
  for (;;) {
    int it;
    if (fuse) {
      __syncthreads();
      if (tidx == 0) *slot25 = (int)atomicAdd(ctr25, 1u);
      __syncthreads();
      it = __builtin_amdgcn_readfirstlane(*slot25);
    } else { it = itn; itn += gridDim.x; }
    if (it >= 512) break;
    const int bh = it >> 5, c = it & 31, b = bh >> 2, h = bh & 3, tok0 = c * 64;
    const size_t grow = (size_t)b * 2048 + tok0;
    if (fuse) panel_wait((unsigned*)(p.ws + OFF_MISC + 2048 + 768) + bh, 4u, tidx);
    if (tidx < 64) ssL[tidx] = 0.f;
    if (wave < 3) {
      const int jt = (wave == 2) ? 1 : 0, i2 = (wave == 0) ? 0 : 1;
      const bf16_t* kd = Kd + (grow + 32 * jt + l31) * 1024 + h * 256 + 8 * hh;
      const bf16_t* q = Qp + (grow + 32 * i2 + l31) * 1024 + h * 256 + 8 * hh;
      f32x16 X;
      for (int g = 0; g < 16; ++g) X[g] = 0.f;
#pragma unroll
      for (int s = 0; s < 16; ++s) X = mfma32(ld16(kd + 16 * s), ld16(q + 16 * s), X);
      if (jt == i2) {
#pragma unroll
        for (int g = 0; g < 16; ++g) { const int jl = (g & 3) + 8 * (g >> 2) + 4 * hh; if (jl > l31) X[g] = 0.f; }
      }
      *(bf16x8*)(smem + (wave * 2 + 0) * 1024 + lane * 16) = cvt8<0>(X);
      *(bf16x8*)(smem + (wave * 2 + 1) * 1024 + lane * 16) = cvt8<1>(X);
    }
    f32x16 o[2][2];
#pragma unroll
    for (int dt = 0; dt < 2; ++dt)
#pragma unroll
      for (int i2 = 0; i2 < 2; ++i2)
#pragma unroll
        for (int q = 0; q < 4; ++q) {
          const size_t idx = ((((size_t)((b * 32 + c) * 4 + h) * 16 + (2 * wave + dt)) * 2 + i2) * 4 + q) * 64 + lane;
          const f32x4 a = unpk4(__builtin_nontemporal_load((const u32x2*)op0 + idx));
          for (int j = 0; j < 4; ++j) o[dt][i2][4 * q + j] = a[j];
        }
    bf16x8 vfr[2][4];
#pragma unroll
    for (int dt = 0; dt < 2; ++dt)
#pragma unroll
      for (int s4 = 0; s4 < 4; ++s4) vfr[dt][s4] = ld16(gvT + ((size_t)(b * 2048 + h * 512 + 64 * wave + 32 * dt + l31)) * 2048 + tok0 + 16 * s4 + 8 * hh);
    __syncthreads();
    {
      const char* lx = smem + lane * 16;
      const bf16x8 x00a = *(const bf16x8*)(lx), x00b = *(const bf16x8*)(lx + 1024), x01a = *(const bf16x8*)(lx + 2048), x01b = *(const bf16x8*)(lx + 3072),
                   x11a = *(const bf16x8*)(lx + 4096), x11b = *(const bf16x8*)(lx + 5120);
#pragma unroll
      for (int dt = 0; dt < 2; ++dt) {
        o[dt][0] = mfma32(vfr[dt][0], x00a, o[dt][0]); o[dt][0] = mfma32(vfr[dt][1], x00b, o[dt][0]);
        o[dt][1] = mfma32(vfr[dt][0], x01a, o[dt][1]); o[dt][1] = mfma32(vfr[dt][1], x01b, o[dt][1]);
        o[dt][1] = mfma32(vfr[dt][2], x11a, o[dt][1]); o[dt][1] = mfma32(vfr[dt][3], x11b, o[dt][1]);
      }
    }
#pragma unroll
    for (int i2 = 0; i2 < 2; ++i2) {
      float ss = 0.f;
#pragma unroll
      for (int dt = 0; dt < 2; ++dt) for (int g = 0; g < 16; ++g) ss += o[dt][i2][g] * o[dt][i2][g];
      ss += __shfl_xor(ss, 32);
      if (hh == 0) atomicAdd(&ssL[32 * i2 + l31], ss);
    }
    __syncthreads();
    {
      char* lw = smem + wave * 16384;
#pragma unroll
      for (int dt = 0; dt < 2; ++dt)
#pragma unroll
        for (int i2 = 0; i2 < 2; ++i2)
#pragma unroll
          for (int q = 0; q < 4; ++q) {
            const f32x4 v = {o[dt][i2][4 * q], o[dt][i2][4 * q + 1], o[dt][i2][4 * q + 2], o[dt][i2][4 * q + 3]};
            const int r = 32 * i2 + l31;
            *(f32x4*)(lw + r * 256 + (((8 * dt + 2 * q + hh) ^ (r & 15)) * 16)) = v;
          }
      asm volatile("s_waitcnt lgkmcnt(0)" ::: "memory");
      u32x2 sgv[16]; f32x4 ghv[16];
#pragma unroll
      for (int i = 0; i < 16; ++i) {
        const int id = i * 64 + lane, r = id >> 4, pos = id & 15, c = pos ^ (r & 15);
        const int dv = 64 * wave + 4 * c;
        sgv[i] = __builtin_nontemporal_load((const u32x2*)(sgg + (grow + r) * 2048 + h * 512 + dv));
        ghv[i] = *(const f32x4*)(p.g_head + dv);
      }
#pragma unroll
      for (int i = 0; i < 16; ++i) {
        const int id = i * 64 + lane, r = id >> 4, pos = id & 15, c = pos ^ (r & 15);
        const f32x4 v = *(const f32x4*)(lw + r * 256 + pos * 16);
        const float rstd = rsqrtf(ssL[r] * (1.f / 512.f) + 1e-6f);
        const int dv = 64 * wave + 4 * c;
        *(u32x2*)(oa + (grow + r) * 2048 + h * 512 + dv) = pk4(v * rstd * ghv[i] * unpk4(sgv[i]));
      }
    }
    __syncthreads();
    if (fuse) panel_publish((unsigned*)(p.ws + OFF_MISC + 2048 + 512) + (b * 8 + (c >> 2)), tidx);
  }
}

DEV void phase3(const Params& p, const bool fuse) {
  EpiMerge e; e.gates = (const bf16_t*)(p.ws + OFF_GATES); e.mg = (float*)(p.ws + OFF_MERGED); e.mbf = (bf16_t*)(p.ws + OFF_MBF);
  unsigned* cnt3 = (unsigned*)(p.ws + OFF_MISC + 2048 + 256);
  for (int L = blockIdx.x; L < 256; L += gridDim.x) {
    const int xcd = L & 7, off = L >> 3, wgid = xcd * 32 + off;
    const int pm = wgid >> 3, pn = wgid & 7;
    const int brow = pm * 256, bcol = pn * 256;
#pragma unroll 1
    for (int step = 0; step < 3; ++step) {
      const bf16_t* a = (const bf16_t*)(p.ws + (step == 0 ? OFF_OB : step == 1 ? OFF_OM : OFF_OA));
      const bf16_t* w = (const bf16_t*)(p.ws + (step == 0 ? OFF_WT_PS : step == 1 ? OFF_WT_PM : OFF_WT_PG));
      if (fuse && step == 0) panel_wait((unsigned*)(p.ws + OFF_MISC + 2048 + 896) + pm, 20u, otid());
      if (fuse && step == 2) panel_wait((unsigned*)(p.ws + OFF_MISC + 2048 + 512) + pm, 16u, otid());
      e.step = step; e.gidx = (step == 0 ? 1 : step == 1 ? 2 : 0);
      gemm_tile<true>(a, w, 2048, brow, bcol, e);
    }
    if (fuse) panel_publish(cnt3 + pm, otid());
  }
}
DEV void p5_rowpair(const Params& p, const int row0, const int lane) {
  const bf16_t* y = (const bf16_t*)(p.ws + OFF_Y);
  const float* part = (const float*)(p.ws + OFF_PART);
  float ss0 = (lane < 32) ? part[(size_t)lane * NTOK + row0] : 0.f;
  float ss1 = (lane < 32) ? part[(size_t)lane * NTOK + row0 + 1] : 0.f;
  u32x2 yv[2][8]; f32x4 xv[2][8];
#pragma unroll
  for (int r = 0; r < 2; ++r)
#pragma unroll
    for (int i = 0; i < 8; ++i) {
      const size_t idx = (size_t)(row0 + r) * DM + 4 * (lane + 64 * i);
      yv[r][i] = __builtin_nontemporal_load((const u32x2*)(y + idx)); xv[r][i] = __builtin_nontemporal_load((const f32x4*)(p.x + idx));
    }
  ss0 = wave_sum(ss0); ss1 = wave_sum(ss1);
  const float rs[2] = {rsqrtf(ss0 * (1.f / DM) + 1e-6f), rsqrtf(ss1 * (1.f / DM) + 1e-6f)};
#pragma unroll
  for (int i = 0; i < 8; ++i) {
    const f32x4 g = *(const f32x4*)(p.g_post + 4 * (lane + 64 * i));
#pragma unroll
    for (int r = 0; r < 2; ++r) {
      const size_t idx = (size_t)(row0 + r) * DM + 4 * (lane + 64 * i);
      __builtin_nontemporal_store(xv[r][i] + unpk4(yv[r][i]) * rs[r] * g, (f32x4*)(p.out + idx));
    }
  }
}
DEV void phase4(const Params& p, const bool fuse) {
  EpiOut e; e.y = (bf16_t*)(p.ws + OFF_Y); e.part = (float*)(p.ws + OFF_PART);
  unsigned* cnt = (unsigned*)(p.ws + OFF_MISC + 2048);
  unsigned* cnt3 = (unsigned*)(p.ws + OFF_MISC + 2048 + 256);
  for (int L = blockIdx.x; L < 256; L += gridDim.x) {
    const int xcd = L & 7, off = L >> 3, wgid = xcd * 32 + off;
    const int pm = wgid >> 3, pn = wgid & 7;
    const int tidx = otid();
    if (fuse) panel_wait(cnt3 + pm, 8u, tidx);
    gemm_tile<true>((const bf16_t*)(p.ws + OFF_MBF), (const bf16_t*)(p.ws + OFF_WT_OUT), 2048, pm * 256, pn * 256, e);
    if (fuse) {
      panel_publish(cnt + pm, tidx);
      panel_wait(cnt + pm, 8u, tidx);
      const int wave = tidx >> 6, lane = tidx & 63;
      const int rbase = pm * 256 + pn * 32 + wave * 4;
      p5_rowpair(p, rbase, lane);
      p5_rowpair(p, rbase + 2, lane);
    }
  }
}
DEV void phase5(const Params& p) {
  const int tidx = otid();
  const int lane = tidx & 63;
  const int gw = blockIdx.x * 8 + (tidx >> 6), nw = gridDim.x * 8;
  for (int row0 = gw * 2; row0 < NTOK; row0 += nw * 2) p5_rowpair(p, row0, lane);
}

__global__ void __launch_bounds__(512) hybrid_layer_megakernel(Params p, int ph_lo, int ph_hi) {
  if (ph_hi == 6 && gridDim.x >= 256) ph_hi = 2;
  for (int ph = ph_lo; ph <= ph_hi; ++ph) {
    for (int rep = 0; rep < ((ph == PROBE_DUP) ? 2 : 1); ++rep) {
      if (rep) cg::this_grid().sync();
      switch (ph) {
        case 0: phase0(p); break;
        case 1: phase1(p, -1); break;
        case 2: phase2(p, rep); if (gridDim.x >= 256) { phase25(p, true); phase3(p, true); phase4(p, true); } break;
        case 3: if (gridDim.x < 256) phase25(p, false); break;
        case 4: if (gridDim.x < 256) phase3(p, false); break;
        case 5: if (gridDim.x < 256) phase4(p, false); break;
        default: if (gridDim.x < 256) phase5(p); break;
      }
    }
    if (ph < ph_hi) { cg::this_grid().sync(); }
  }
}

extern "C" void kernel_launch(void* const* d_in, const int* in_sizes, int n_in, void* d_out, int out_size, void* d_ws, size_t ws_size,
                              hipStream_t stream) {
  constexpr size_t kDynLds = 131072 + 4096 + 16384;
  static int grid_blocks = 0;
  if (!grid_blocks) {
    hipFuncSetAttribute((const void*)hybrid_layer_megakernel, hipFuncAttributeMaxDynamicSharedMemorySize, (int)kDynLds);
    int dev = 0, cus = 0, per_cu = 0;
    hipGetDevice(&dev);
    hipDeviceGetAttribute(&cus, hipDeviceAttributeMultiprocessorCount, dev);
    hipOccupancyMaxActiveBlocksPerMultiprocessor(&per_cu, hybrid_layer_megakernel, 512, kDynLds);
    if (per_cu < 1) per_cu = 1;
    if (per_cu > 1) per_cu = 1;
    grid_blocks = cus * per_cu;
  }
  Params p{};
  p.x = (const float*)d_in[0]; p.mem = (const float*)d_in[1]; p.g_pre = (const float*)d_in[2]; p.g_post = (const float*)d_in[3];
  p.g_mem = (const float*)d_in[4]; p.w_in = (const float*)d_in[5]; p.a_w2 = (const float*)d_in[6]; p.a_b = (const float*)d_in[7];
  p.g_head = (const float*)d_in[8]; p.w_mkv = (const float*)d_in[9]; p.w_pg = (const float*)d_in[10]; p.w_ps = (const float*)d_in[11];
  p.w_pm = (const float*)d_in[12]; p.w_out = (const float*)d_in[13];
  p.out = (float*)d_out; p.ws = (char*)d_ws;
  hipMemsetAsync((char*)d_ws + OFF_MISC, 0, 4096, stream);
#if MK_MULTI
  for (int ph = 0; ph <= 6; ++ph) hipLaunchKernelGGL(hybrid_layer_megakernel, dim3(grid_blocks), dim3(512), kDynLds, stream, p, ph, ph);
#else
  int lo = 0, hi = 6;
  void* args[] = {&p, &lo, &hi};
  hipError_t e = hipLaunchCooperativeKernel((const void*)hybrid_layer_megakernel, dim3(grid_blocks), dim3(512), args, kDynLds, stream);
  if (e != hipSuccess) fprintf(stderr, "cooperative launch failed: %s (grid %d)\n", hipGetErrorString(e), grid_blocks);
#endif
}
```

```cpp
#include <hip/hip_runtime.h>
#include <hip/hip_cooperative_groups.h>
#include <cstdio>
namespace cg = cooperative_groups;

#ifndef PROBE_DUP
#define PROBE_DUP -1
#endif
#ifndef PROBE_PART
#define PROBE_PART 7
#endif
#ifndef MK_MULTI
#define MK_MULTI 0
#endif

typedef unsigned short bf16_t;
typedef short bf16x8 __attribute__((ext_vector_type(8)));
typedef float f32x2 __attribute__((ext_vector_type(2)));
typedef float f32x4 __attribute__((ext_vector_type(4)));
typedef float f32x16 __attribute__((ext_vector_type(16)));
typedef unsigned u32x2 __attribute__((ext_vector_type(2)));
typedef unsigned u32x4 __attribute__((ext_vector_type(4)));
typedef __bf16 bf16x2_t __attribute__((ext_vector_type(2)));
#define DEV __device__ __forceinline__

constexpr int NTOK = 8192, DM = 2048, NPROJ = 22528;
constexpr size_t MiB = 1048576;
constexpr size_t OFF_WT_IN = 0, OFF_WT_MKV = 88 * MiB, OFF_WT_PG = 104 * MiB, OFF_WT_PS = 112 * MiB, OFF_WT_PM = 120 * MiB, OFF_WT_OUT = 128 * MiB,
                 OFF_H = 136 * MiB, OFF_MEMH = 168 * MiB, OFF_B = 172 * MiB, OFF_EB = 204 * MiB, OFF_MISC = 206 * MiB,
                 OFF_QP = 208 * MiB, OFF_KDP = 224 * MiB, OFF_KET = 240 * MiB, OFF_GVT = 256 * MiB, OFF_SGG = 288 * MiB, OFF_SQ = 320 * MiB,
                 OFF_SK = 352 * MiB, OFF_SVT = 384 * MiB, OFF_SSG = 416 * MiB, OFF_MQ = 448 * MiB, OFF_GATES = 480 * MiB, OFF_MK = 576 * MiB,
                 OFF_MVT = 580 * MiB;
constexpr size_t OFF_OP0 = OFF_WT_IN, OFF_OP1 = 584 * MiB, OFF_OB = OFF_H, OFF_OM = OFF_B, OFF_OA = 32 * MiB, OFF_MERGED = 584 * MiB, OFF_MBF = 616 * MiB, OFF_Y = 648 * MiB;
constexpr size_t OFF_PART = OFF_MISC + 4096;

struct Params {
  const float *x, *mem, *g_pre, *g_post, *g_mem, *w_in, *a_w2, *a_b, *g_head, *w_mkv, *w_pg, *w_ps, *w_pm, *w_out;
  float* out; char* ws;
};

extern __shared__ __attribute__((aligned(16))) char smem[];

DEV unsigned pk_bf16(float a, float b) { f32x2 v = {a, b}; bf16x2_t r = __builtin_convertvector(v, bf16x2_t); return __builtin_bit_cast(unsigned, r); }
DEV float bf_lo(unsigned u) { return __uint_as_float(u << 16); }
DEV float bf_hi(unsigned u) { return __uint_as_float(u & 0xffff0000u); }
DEV float wave_sum(float v) { for (int o = 32; o; o >>= 1) v += __shfl_xor(v, o); return v; }
DEV bf16x8 ld16(const bf16_t* p) { return *(const bf16x8*)p; }
DEV f32x16 mfma32(bf16x8 a, bf16x8 b, f32x16 c) { return __builtin_amdgcn_mfma_f32_32x32x16_bf16(a, b, c, 0, 0, 0); }
template <int S> DEV bf16x8 cvt8(const f32x16& v) {
  u32x4 p = {pk_bf16(v[8 * S], v[8 * S + 1]), pk_bf16(v[8 * S + 2], v[8 * S + 3]), pk_bf16(v[8 * S + 4], v[8 * S + 5]), pk_bf16(v[8 * S + 6], v[8 * S + 7])};
  return __builtin_bit_cast(bf16x8, p);
}
DEV u32x2 pk4(f32x4 v) { u32x2 r = {pk_bf16(v[0], v[1]), pk_bf16(v[2], v[3])}; return r; }
DEV f32x4 unpk4(u32x2 u) { f32x4 r = {bf_lo(u[0]), bf_hi(u[0]), bf_lo(u[1]), bf_hi(u[1])}; return r; }
DEV int sig4(int x) { return ((x & 1) << 1) | (x >> 1); }
DEV int sig16(int p) { return 8 * ((p >> 2) & 1) + 4 * (p >> 3) + (p & 3); }
DEV int otid() { int t = threadIdx.x; asm volatile("" : "+v"(t)); return t; }
DEV float fsigmoid(float x) { return 1.f / (1.f + __expf(-x)); }
DEV float logsigmoid(float x) { return fminf(x, 0.f) - __logf(1.f + __expf(-fabsf(x))); }

constexpr int BM = 256, BK = 64, HALF = 128, HT = HALF * BK;
DEV int lds_byte(int r, int c) { int st = (r >> 4) * 2 + (c >> 5), rr = r & 15, cc = c & 31, ob = rr * 64 + cc * 2; return st * 1024 + (ob ^ (((ob >> 9) & 1) << 5)); }
DEV void stage_rc(int b, int& R, int& C) { int st = b / 1024, sb = b % 1024, swz = sb ^ (((sb >> 9) & 1) << 5); R = (st >> 1) * 16 + swz / 64; C = (st & 1) * 32 + (swz % 64) / 2; }

template <bool SWAP, class Epi>
DEV void gemm_tile(const bf16_t* __restrict__ A, const bf16_t* __restrict__ Bt, const int K, const int brow, const int bcol, const Epi& epi) {
  bf16_t* shm = (bf16_t*)smem;
#define SA(b, h) (shm + ((b) * 2 + (h)) * HT)
#define SB(b, h) (shm + (4 + (b) * 2 + (h)) * HT)
#define STAGE(P, BASE, br, kt) do { const char* _gb = (const char*)(BASE) + (((long)(br) * K + (long)(kt) * BK) << 1); \
    __builtin_amdgcn_global_load_lds((const unsigned*)(_gb + so0), (unsigned*)((char*)(P) + tb), 16, 0, 0); \
    __builtin_amdgcn_global_load_lds((const unsigned*)(_gb + so1), (unsigned*)((char*)(P) + tb + 8192), 16, 0, 0); } while (0)
#define LDA(dst, b, h) for (int m = 0; m < 4; ++m) for (int k = 0; k < 2; ++k) \
    dst[m][k] = *reinterpret_cast<const bf16x8*>((char*)SA(b, h) + a_rd + m * 2048 + k * 1024)
#define LDB(dst, b, h) for (int n = 0; n < 2; ++n) for (int k = 0; k < 2; ++k) \
    dst[n][k] = *reinterpret_cast<const bf16x8*>((char*)SB(b, h) + b_rd + n * 2048 + k * 1024)
#define MMA(ai, bj, At_, Bt_) do { __builtin_amdgcn_s_setprio(1); \
    for (int m = 0; m < 4; ++m) for (int n = 0; n < 2; ++n) for (int k = 0; k < 2; ++k) \
      acc[ai][bj][m][n] = SWAP ? __builtin_amdgcn_mfma_f32_16x16x32_bf16(Bt_[n][k], At_[m][k], acc[ai][bj][m][n], 0, 0, 0) \
                               : __builtin_amdgcn_mfma_f32_16x16x32_bf16(At_[m][k], Bt_[n][k], acc[ai][bj][m][n], 0, 0, 0); \
    __builtin_amdgcn_s_setprio(0); } while (0)
#define WAIT_V(n) asm volatile("s_waitcnt vmcnt(" #n ")" ::: "memory")
#define WAIT_L(n) asm volatile("s_waitcnt lgkmcnt(" #n ")" ::: "memory")
#define BAR __builtin_amdgcn_s_barrier()
#define SCHED __builtin_amdgcn_sched_barrier(0)
  const int tidx = otid();
  const int wid = tidx >> 6, lane = tidx & 63, wr = wid >> 2, wc = wid & 3, fr = lane & 15, fq = lane >> 4;
  f32x4 acc[2][2][4][2] = {};
  bf16x8 At[4][2], B0[2][2], B1[2][2];
  const int nt = K / BK;
  const int tb = tidx * 16;
  unsigned so0, so1;
  { int r_, c_; stage_rc(tb, r_, c_); so0 = (unsigned)(r_ * K + c_) * 2u; stage_rc(tb + 8192, r_, c_); so1 = (unsigned)(r_ * K + c_) * 2u; }
  const int tb16 = (fr * 64 + fq * 16) ^ ((fr >> 3) << 5);
  const int a_rd = wr * 8192 + tb16, b_rd = wc * 4096 + tb16;
  WAIT_V(0);
  __syncthreads();
  STAGE(SB(0, 0), Bt, bcol, 0); STAGE(SA(0, 0), A, brow, 0);
  STAGE(SB(0, 1), Bt, bcol + HALF, 0); STAGE(SA(0, 1), A, brow + HALF, 0);
  if (wr == 1) BAR;
  WAIT_V(4); BAR;
  STAGE(SB(1, 0), Bt, bcol, 1); STAGE(SA(1, 0), A, brow, 1); STAGE(SB(1, 1), Bt, bcol + HALF, 1);
  WAIT_V(6); BAR;
#pragma unroll 1
  for (int t = 0; t < nt - 2; t += 2) {
    LDB(B0, 0, 0); SCHED; LDA(At, 0, 0); STAGE(SA(1, 1), A, brow + HALF, t + 1);
    WAIT_L(8); BAR; WAIT_L(0); MMA(0, 0, At, B0); BAR; SCHED;
    LDB(B1, 0, 1); STAGE(SB(0, 0), Bt, bcol, t + 2);
    BAR; WAIT_L(0); MMA(0, 1, At, B1); BAR;
    LDA(At, 0, 1); STAGE(SA(0, 0), A, brow, t + 2);
    BAR; WAIT_L(0); MMA(1, 0, At, B0); BAR; SCHED;
    STAGE(SB(0, 1), Bt, bcol + HALF, t + 2);
    WAIT_V(6); BAR; MMA(1, 1, At, B1); BAR;
    LDB(B0, 1, 0); SCHED; LDA(At, 1, 0); STAGE(SA(0, 1), A, brow + HALF, t + 2);
    WAIT_L(8); BAR; WAIT_L(0); MMA(0, 0, At, B0); BAR; SCHED;
    LDB(B1, 1, 1); STAGE(SB(1, 0), Bt, bcol, t + 3);
    BAR; WAIT_L(0); MMA(0, 1, At, B1); BAR;
    LDA(At, 1, 1); STAGE(SA(1, 0), A, brow, t + 3);
    BAR; WAIT_L(0); MMA(1, 0, At, B0); BAR; SCHED;
    STAGE(SB(1, 1), Bt, bcol + HALF, t + 3);
    WAIT_V(6); BAR; MMA(1, 1, At, B1); BAR;
  }
  { LDB(B0, 0, 0); LDA(At, 0, 0); STAGE(SA(1, 1), A, brow + HALF, nt - 1);
    BAR; WAIT_L(0); MMA(0, 0, At, B0); BAR;
    LDB(B1, 0, 1); BAR; WAIT_L(0); MMA(0, 1, At, B1); BAR;
    LDA(At, 0, 1); WAIT_V(4); BAR; WAIT_L(0); MMA(1, 0, At, B0); MMA(1, 1, At, B1); BAR; }
  { LDB(B0, 1, 0); LDA(At, 1, 0); WAIT_V(2); BAR; WAIT_L(0); MMA(0, 0, At, B0); BAR;
    LDB(B1, 1, 1); WAIT_V(0); BAR; WAIT_L(0); MMA(0, 1, At, B1); BAR;
    LDA(At, 1, 1); BAR; WAIT_L(0); MMA(1, 0, At, B0); MMA(1, 1, At, B1); BAR; }
  if (wr == 0) BAR;
  {
    int tx = tidx, br2 = brow, bc2 = bcol;
    asm volatile("" : "+v"(tx), "+s"(br2), "+s"(bc2));
    const int wid2 = tx >> 6, lane2 = tx & 63;
    epi(acc, br2, bc2, wid2 >> 2, wid2 & 3, lane2 & 15, lane2 >> 4);
  }
#undef SA
#undef SB
}

template <bool NT = false>
DEV void tile_rows_out(bf16_t* __restrict__ out0, const size_t ld, const int tid) {
#pragma unroll
  for (int i = 0; i < 16; ++i) {
    const int id = i * 512 + tid, r = id >> 5, pos = id & 31, c = pos ^ (r & 31);
    const u32x4 v = *(const u32x4*)(smem + r * 512 + pos * 16);
    if (NT) __builtin_nontemporal_store(v, (u32x4*)(out0 + (size_t)r * ld + 8 * c)); else *(u32x4*)(out0 + (size_t)r * ld + 8 * c) = v;
  }
}
DEV void tile_rows_in(const bf16_t* __restrict__ src0, const size_t ld, const int tid) {
#pragma unroll 1
  for (int io = 0; io < 4; ++io) {
    u32x4 v[4];
#pragma unroll
    for (int ii = 0; ii < 4; ++ii) {
      const int id = (io * 4 + ii) * 512 + tid, r = id >> 5, pos = id & 31, c = pos ^ (r & 31);
      v[ii] = __builtin_nontemporal_load((const u32x4*)(src0 + (size_t)r * ld + 8 * c));
    }
#pragma unroll
    for (int ii = 0; ii < 4; ++ii) {
      const int id = (io * 4 + ii) * 512 + tid, r = id >> 5, pos = id & 31;
      *(u32x4*)(smem + r * 512 + pos * 16) = v[ii];
    }
  }
}
DEV u32x2 tile_get4(const int r, const int col4) { return *(const u32x2*)(smem + r * 512 + ((((col4 >> 3)) ^ (r & 31)) * 16) + ((col4 & 4) << 1)); }
DEV void tile_put4(const int r, const int col4, const u32x2 v) {
  *(u32x2*)(smem + r * 512 + ((((col4 >> 3)) ^ (r & 31)) * 16) + ((col4 & 4) << 1)) = v;
}
struct EpiP1 {
  int mode;
  bf16_t* out; int ld; int segstart; float scale; const float* bmat; bf16_t* keT;
  DEV void operator()(f32x4 (&acc)[2][2][4][2], int brow, int bcol, int wr, int wc, int fr, int fq) const {
#pragma unroll
    for (int ai = 0; ai < 2; ++ai)
#pragma unroll
      for (int m = 0; m < 4; ++m) {
        const int rl = ai * 128 + wr * 64 + m * 16 + fr, tok = brow + rl;
#pragma unroll
        for (int bj = 0; bj < 2; ++bj)
#pragma unroll
          for (int n = 0; n < 2; ++n) {
            const int cl = bj * 128 + wc * 32 + n * 16 + fq * 4, lc = bcol - segstart + cl;
            f32x4 v = acc[ai][bj][m][n];
            if (mode == 0) {
              tile_put4(rl, cl, pk4(v * scale));
            } else if (mode == 1) {
              for (int j = 0; j < 4; ++j) v[j] = v[j] * fsigmoid(v[j]);
              tile_put4(rl, cl, pk4(v));
            } else if (mode == 2) {
              for (int j = 0; j < 4; ++j) v[j] = fsigmoid(v[j]);
              tile_put4(rl, cl, pk4(v));
            } else {
              const f32x4 b4 = *(const f32x4*)(bmat + (size_t)tok * 1024 + lc);
              const int pcl = (cl & ~15) + 4 * sig4((cl >> 2) & 3);
              if (mode == 3) {
                for (int j = 0; j < 4; ++j) v[j] = v[j] * scale * __expf(b4[j]);
                tile_put4(rl, pcl, pk4(v));
              } else {
                const f32x4 bl = *(const f32x4*)(bmat + (size_t)(tok | 63) * 1024 + lc);
                f32x4 kd, ke;
                for (int j = 0; j < 4; ++j) { kd[j] = v[j] * __expf(-b4[j]); ke[j] = v[j] * __expf(bl[j] - b4[j]); }
                tile_put4(rl, pcl, pk4(kd));
                (void)ke;
              }
            }
          }
      }
    __syncthreads();
    tile_rows_out<true>(out + (size_t)brow * ld + (bcol - segstart), (size_t)ld, (wr * 4 + wc) * 64 + fq * 16 + fr);
    if (mode == 4) {
      __syncthreads();
#pragma unroll
      for (int ai = 0; ai < 2; ++ai)
#pragma unroll
        for (int m = 0; m < 4; ++m) {
          const int rl = ai * 128 + wr * 64 + m * 16 + fr, tok = brow + rl;
          const int tposl = (rl & ~15) + sig16(rl & 15);
#pragma unroll
          for (int bj = 0; bj < 2; ++bj)
#pragma unroll
            for (int n = 0; n < 2; ++n) {
              const int cl = bj * 128 + wc * 32 + n * 16 + fq * 4, lc = bcol - segstart + cl;
              const f32x4 v = acc[ai][bj][m][n];
              const f32x4 b4 = *(const f32x4*)(bmat + (size_t)tok * 1024 + lc);
              const f32x4 bl = *(const f32x4*)(bmat + (size_t)(tok | 63) * 1024 + lc);
              const u32x2 kk = pk4((f32x4){v[0] * __expf(bl[0] - b4[0]), v[1] * __expf(bl[1] - b4[1]), v[2] * __expf(bl[2] - b4[2]), v[3] * __expf(bl[3] - b4[3])});
#pragma unroll
              for (int j = 0; j < 4; ++j) {
                const int row = cl + j;
                const unsigned short val = (unsigned short)((j & 1) ? (kk[j >> 1] >> 16) : (kk[j >> 1] & 0xffff));
                *(unsigned short*)(smem + row * 512 + (((tposl >> 3) ^ (row & 31)) * 16) + (tposl & 7) * 2) = val;
              }
            }
        }
      __syncthreads();
      const int bt = brow >> 11, tl0 = brow & 2047, hd = (bcol - segstart) >> 8;
      tile_rows_out<true>(keT + ((size_t)((bt * 4 + hd) * 256)) * 2048 + tl0, 2048, (wr * 4 + wc) * 64 + fq * 16 + fr);
    }
  }
};
struct EpiVT {
  bf16_t* out; int nch; int tshift; int segstart;
  DEV void operator()(f32x4 (&acc)[2][2][4][2], int brow, int bcol, int wr, int wc, int fr, int fq) const {
    const int T = 1 << tshift;
#pragma unroll
    for (int ai = 0; ai < 2; ++ai)
#pragma unroll
      for (int m = 0; m < 4; ++m) {
        const int tposl = ai * 128 + wr * 64 + m * 16 + 4 * sig4(fq);
#pragma unroll
        for (int bj = 0; bj < 2; ++bj)
#pragma unroll
          for (int n = 0; n < 2; ++n) tile_put4(bj * 128 + wc * 32 + n * 16 + fr, tposl, pk4(acc[ai][bj][m][n]));
      }
    __syncthreads();
    const int bt = brow >> tshift, tl0 = brow & (T - 1);
    tile_rows_out<true>(out + ((size_t)(bt * nch + (bcol - segstart)) << tshift) + tl0, (size_t)T, (wr * 4 + wc) * 64 + fq * 16 + fr);
  }
};
struct EpiMerge {
  int step; int gidx; const bf16_t* gates; float* mg; bf16_t* mbf;
  DEV void operator()(f32x4 (&acc)[2][2][4][2], int brow, int bcol, int wr, int wc, int fr, int fq) const {
    const int tid = (wr * 4 + wc) * 64 + fq * 16 + fr;
    u32x2* sp = (u32x2*)mg + ((size_t)((brow >> 8) * 8 + (bcol >> 8)) * 32) * 512 + tid;
    tile_rows_in(gates + (size_t)brow * 6144 + gidx * 2048 + bcol, 6144, tid);
    __syncthreads();
#pragma unroll
    for (int ai = 0; ai < 2; ++ai)
#pragma unroll
      for (int m = 0; m < 4; ++m) {
        const int rl = ai * 128 + wr * 64 + m * 16 + fr, tok = brow + rl;
#pragma unroll
        for (int bj = 0; bj < 2; ++bj)
#pragma unroll
          for (int n = 0; n < 2; ++n) {
            const int cl = bj * 128 + wc * 32 + n * 16 + fq * 4, col = bcol + cl;
            const int f = ((ai * 4 + m) * 2 + bj) * 2 + n;
            const f32x4 g = unpk4(tile_get4(rl, cl));
            f32x4 v = acc[ai][bj][m][n] * g;
            if (step == 0) sp[(size_t)f * 512] = pk4(v);
            else if (step == 1) sp[(size_t)f * 512] = pk4(unpk4(sp[(size_t)f * 512]) + v);
            else tile_put4(rl, cl, pk4(unpk4(sp[(size_t)f * 512]) + v));
          }
      }
    if (step == 2) {
      __syncthreads();
      tile_rows_out(mbf + (size_t)brow * 2048 + bcol, 2048, tid);
    }
  }
};
struct EpiOut {
  bf16_t* y; float* part;
  DEV void operator()(f32x4 (&acc)[2][2][4][2], int brow, int bcol, int wr, int wc, int fr, int fq) const {
    const int tid = (wr * 4 + wc) * 64 + fq * 16 + fr;
#pragma unroll
    for (int ai = 0; ai < 2; ++ai)
#pragma unroll
      for (int m = 0; m < 4; ++m) {
        const int rl = ai * 128 + wr * 64 + m * 16 + fr, tok = brow + rl;
        float ss = 0.f;
#pragma unroll
        for (int bj = 0; bj < 2; ++bj)
#pragma unroll
          for (int n = 0; n < 2; ++n) {
            const int cl = bj * 128 + wc * 32 + n * 16 + fq * 4;
            const f32x4 v = acc[ai][bj][m][n];
            tile_put4(rl, cl, pk4(v));
            ss += v[0] * v[0] + v[1] * v[1] + v[2] * v[2] + v[3] * v[3];
          }
        ss += __shfl_xor(ss, 16); ss += __shfl_xor(ss, 32);
        if (fq == 0) part[(size_t)((bcol >> 8) * 4 + wc) * NTOK + tok] = ss;
      }
    __syncthreads();
    tile_rows_out(y + (size_t)brow * 2048 + bcol, 2048, tid);
  }
};

DEV void norm_rows64(const float* __restrict__ src, const float* __restrict__ g, bf16_t* __restrict__ dst, int r0) {
  const int tidx = otid();
  const int wave = tidx >> 6, lane = tidx & 63;
  for (int rr = 0; rr < 8; rr += 2) {
    const int row = r0 + wave * 8 + rr;
    const f32x4* xr = (const f32x4*)(src + (size_t)row * DM);
    f32x4 v[2][8]; float ss0 = 0.f, ss1 = 0.f;
#pragma unroll
    for (int i = 0; i < 8; ++i) { v[0][i] = __builtin_nontemporal_load(xr + lane + 64 * i); v[1][i] = __builtin_nontemporal_load(xr + 512 + lane + 64 * i); }
#pragma unroll
    for (int i = 0; i < 8; ++i) {
      ss0 += v[0][i][0] * v[0][i][0] + v[0][i][1] * v[0][i][1] + v[0][i][2] * v[0][i][2] + v[0][i][3] * v[0][i][3];
      ss1 += v[1][i][0] * v[1][i][0] + v[1][i][1] * v[1][i][1] + v[1][i][2] * v[1][i][2] + v[1][i][3] * v[1][i][3];
    }
    ss0 = wave_sum(ss0); ss1 = wave_sum(ss1);
    const float rs[2] = {rsqrtf(ss0 * (1.f / DM) + 1e-6f), rsqrtf(ss1 * (1.f / DM) + 1e-6f)};
#pragma unroll
    for (int i = 0; i < 8; ++i) {
      const f32x4 g4 = ((const f32x4*)g)[lane + 64 * i];
#pragma unroll
      for (int r = 0; r < 2; ++r) *(u32x2*)(dst + (size_t)(row + r) * DM + 4 * (lane + 64 * i)) = pk4(v[r][i] * rs[r] * g4);
    }
  }
}

DEV void p0_chunk(const Params& p, int item) {
  const int tid = otid(), wave = tid >> 6, lane = tid & 63;
  const int r0 = item * 64;
  bf16_t* h = (bf16_t*)(p.ws + OFF_H);
  norm_rows64(p.x, p.g_pre, h, r0);
  __syncthreads();
  float* gaL = (float*)smem;
  {
    const int row = lane & 15, kg = lane >> 4, tg = wave & 3, kh = wave >> 2;
    const bf16_t* ap = h + (size_t)(r0 + tg * 16 + row) * DM + 8 * kg + 1024 * kh;
    const float* wp = p.w_in + (size_t)(8 * kg + 1024 * kh) * 22544 + 6144 + row;
    f32x4 acc = {0.f, 0.f, 0.f, 0.f};
#pragma unroll 8
    for (int s = 0; s < 32; ++s) {
      const bf16x8 a = ld16(ap + 32 * s);
      float w[8];
#pragma unroll
      for (int e = 0; e < 8; ++e) w[e] = wp[(size_t)(32 * s + e) * 22544];
      u32x4 bw = {pk_bf16(w[0], w[1]), pk_bf16(w[2], w[3]), pk_bf16(w[4], w[5]), pk_bf16(w[6], w[7])};
      acc = __builtin_amdgcn_mfma_f32_16x16x32_bf16(a, __builtin_bit_cast(bf16x8, bw), acc, 0, 0, 0);
    }
#pragma unroll
    for (int j = 0; j < 4; ++j) gaL[kh * 1024 + (tg * 16 + kg * 4 + j) * 16 + row] = acc[j];
  }
  __syncthreads();
  float* bmat = (float*)(p.ws + OFF_B);
  float* eb = (float*)(p.ws + OFF_EB);
  float w2c[2][16], bias[2], run[2] = {0.f, 0.f};
#pragma unroll
  for (int k = 0; k < 2; ++k) {
    const int c = tid + 512 * k;
    bias[k] = p.a_b[c];
#pragma unroll
    for (int r = 0; r < 16; ++r) w2c[k][r] = p.a_w2[r * 1024 + c];
  }
  for (int tok = 0; tok < 64; ++tok) {
    float g[16];
#pragma unroll
    for (int q = 0; q < 4; ++q) { const f32x4 t4 = *(const f32x4*)(gaL + tok * 16 + 4 * q) + *(const f32x4*)(gaL + 1024 + tok * 16 + 4 * q); g[4 * q] = t4[0]; g[4 * q + 1] = t4[1]; g[4 * q + 2] = t4[2]; g[4 * q + 3] = t4[3]; }
#pragma unroll
    for (int k = 0; k < 2; ++k) {
      float xv = bias[k];
#pragma unroll
      for (int r = 0; r < 16; ++r) xv += g[r] * w2c[k][r];
      run[k] += logsigmoid(xv) * (1.f / 16.f);
      bmat[(size_t)(r0 + tok) * 1024 + tid + 512 * k] = run[k];
    }
  }
#pragma unroll
  for (int k = 0; k < 2; ++k) eb[(size_t)item * 1024 + tid + 512 * k] = __expf(run[k]);
  __syncthreads();
}

DEV void p0_transpose8(const Params& p, int nt2, int kq) {
  const float* src; int ld, scol; bf16_t* dst;
  const int nt = nt2 * 2;
  if (nt < 352) { const int c = nt * 64; src = p.w_in; ld = 22544; scol = c + (c >= 6144 ? 16 : 0); dst = (bf16_t*)(p.ws + OFF_WT_IN) + (size_t)c * 2048; }
  else if (nt < 416) { const int c = (nt - 352) * 64; src = p.w_mkv; ld = 4096; scol = c; dst = (bf16_t*)(p.ws + OFF_WT_MKV) + (size_t)c * 2048; }
  else if (nt < 448) { const int c = (nt - 416) * 64; src = p.w_pg; ld = 2048; scol = c; dst = (bf16_t*)(p.ws + OFF_WT_PG) + (size_t)c * 2048; }
  else if (nt < 480) { const int c = (nt - 448) * 64; src = p.w_ps; ld = 2048; scol = c; dst = (bf16_t*)(p.ws + OFF_WT_PS) + (size_t)c * 2048; }
  else if (nt < 512) { const int c = (nt - 480) * 64; src = p.w_pm; ld = 2048; scol = c; dst = (bf16_t*)(p.ws + OFF_WT_PM) + (size_t)c * 2048; }
  else { const int c = (nt - 512) * 64; src = p.w_out; ld = 2048; scol = c; dst = (bf16_t*)(p.ws + OFF_WT_OUT) + (size_t)c * 2048; }
  const int t = otid();
  const int k0 = kq * 256;
  unsigned* T32 = (unsigned*)smem;
  {
    const int r2 = t >> 5, c4 = t & 31;
    const float* sp = src + (size_t)(k0 + 2 * r2) * ld + scol + 4 * c4;
    f32x4 v0[8], v1[8];
#pragma unroll
    for (int kk = 0; kk < 8; ++kk) {
      v0[kk] = __builtin_nontemporal_load((const f32x4*)(sp + (size_t)(kk * 32) * ld)); v1[kk] = __builtin_nontemporal_load((const f32x4*)(sp + (size_t)(kk * 32 + 1) * ld)); }
#pragma unroll
    for (int kk = 0; kk < 8; ++kk)
#pragma unroll
      for (int j = 0; j < 4; ++j) T32[(kk * 128 + 4 * c4 + j) * 17 + r2] = pk_bf16(v0[kk][j], v1[kk][j]);
  }
  __syncthreads();
  {
    const int n = t >> 2, g = t & 3;
#pragma unroll
    for (int i = 0; i < 8; ++i) {
      const int ch = g + 4 * i, kk = ch >> 2, w4 = (ch & 3) * 4;
      const unsigned* tp = T32 + (kk * 128 + n) * 17 + w4;
      const u32x4 w = {tp[0], tp[1], tp[2], tp[3]};
      *(u32x4*)(dst + (size_t)n * 2048 + k0 + 8 * ch) = w;
    }
  }
  __syncthreads();
}

DEV void phase0(const Params& p) {
  const int tidx = otid();
  unsigned* ctr = (unsigned*)(p.ws + OFF_MISC + 512);
  volatile int* slot = (volatile int*)(smem + 131072 + 2048);
  const int total = 128 + 16 + 272 * 8;
  bool first = true;
  while (true) {
    __syncthreads();
    if (tidx == 0) *slot = first ? (int)blockIdx.x : (int)(gridDim.x + atomicAdd(ctr, 1u));
    first = false;
    __syncthreads();
    const int it = __builtin_amdgcn_readfirstlane(*slot);
    if (it >= total) break;
    if (it < 128) p0_chunk(p, it);
    else if (it < 144) { norm_rows64(p.mem, p.g_mem, (bf16_t*)(p.ws + OFF_MEMH), (it - 128) * 64); }
    else { const int tt = it - 144; p0_transpose8(p, tt >> 3, tt & 7); }
  }
}

#define MKV_IN_P2 1
DEV void phase1(const Params& p, const int base_item) {
  const int nwg = MKV_IN_P2 ? 2816 : 2816 + 64;
  const int Lbeg = base_item >= 0 ? base_item : (int)blockIdx.x, Lend = base_item >= 0 ? base_item + 1 : nwg;
#pragma unroll 1
  for (int L = Lbeg; L < Lend; L += gridDim.x) {
    const bf16_t* a; const bf16_t* w; int brow, bcol; bool vt;
    EpiVT ev; EpiP1 e;
    e.bmat = (const float*)(p.ws + OFF_B); e.keT = (bf16_t*)(p.ws + OFF_KET); e.ld = 2048; e.scale = 1.f; e.mode = 0; e.out = nullptr; e.segstart = 0;
    ev.out = nullptr; ev.nch = 2048; ev.tshift = 11; ev.segstart = 0;
    if (L < 2816) {
      const int xcd = L & 7, off = L >> 3, wgid = xcd * 352 + off;
      const int nig = 8 * 88, gid = wgid / nig, pm = gid * 8 + (wgid % nig) % 8, pn = (wgid % nig) / 8;
      brow = pm * 256; bcol = pn * 256;
      a = (const bf16_t*)(p.ws + OFF_H); w = (const bf16_t*)(p.ws + OFF_WT_IN);
      vt = (bcol >= 2048 && bcol < 4096) || (bcol >= 10240 && bcol < 12288);
      if (vt) {
        if (bcol < 4096) { ev.out = (bf16_t*)(p.ws + OFF_GVT); ev.segstart = 2048; } else { ev.out = (bf16_t*)(p.ws + OFF_SVT); ev.segstart = 10240; }
      } else {
        if (bcol < 1024) { e.mode = 3; e.out = (bf16_t*)(p.ws + OFF_QP); e.segstart = 0; e.scale = 1.f / 16.f; e.ld = 1024; }
        else if (bcol < 2048) { e.mode = 4; e.out = (bf16_t*)(p.ws + OFF_KDP); e.segstart = 1024; e.ld = 1024; }
        else if (bcol < 6144) { e.mode = 1; e.out = (bf16_t*)(p.ws + OFF_SGG); e.segstart = 4096; }
        else if (bcol < 8192) { e.mode = 0; e.out = (bf16_t*)(p.ws + OFF_SQ); e.segstart = 6144; e.scale = 0.08838834764831845f * 1.4426950408889634f; }
        else if (bcol < 10240) { e.mode = 0; e.out = (bf16_t*)(p.ws + OFF_SK); e.segstart = 8192; }
        else if (bcol < 14336) { e.mode = 1; e.out = (bf16_t*)(p.ws + OFF_SSG); e.segstart = 12288; }
        else if (bcol < 16384) { e.mode = 0; e.out = (bf16_t*)(p.ws + OFF_MQ); e.segstart = 14336; e.scale = 0.04419417382415922f; }
        else { e.mode = 2; e.out = (bf16_t*)(p.ws + OFF_GATES); e.segstart = 16384; e.ld = 6144; }
      }
    } else {
      const int l = L - 2816, pm = l & 3, pn = l >> 2;
      brow = pm * 256; bcol = pn * 256;
      a = (const bf16_t*)(p.ws + OFF_MEMH); w = (const bf16_t*)(p.ws + OFF_WT_MKV);
      vt = bcol >= 2048;
      if (vt) { ev.out = (bf16_t*)(p.ws + OFF_MVT); ev.tshift = 8; ev.segstart = 2048; }
      else { e.mode = 0; e.out = (bf16_t*)(p.ws + OFF_MK); }
    }
    if (vt) gemm_tile<false>(a, w, 2048, brow, bcol, ev);
    else gemm_tile<true>(a, w, 2048, brow, bcol, e);
  }
}

DEV void panel_publish(unsigned* cnt, const int tidx) {
  asm volatile("s_waitcnt vmcnt(0)" ::: "memory");
  __syncthreads();
  if (tidx == 0) {
    __builtin_amdgcn_fence(__ATOMIC_RELEASE, "agent");
    asm volatile("s_waitcnt vmcnt(0)" ::: "memory");
    __hip_atomic_fetch_add(cnt, 1u, __ATOMIC_RELAXED, __HIP_MEMORY_SCOPE_AGENT);
  }
}
DEV void panel_wait(unsigned* cnt, const unsigned need, const int tidx) {
  if (tidx == 0) {
    while (__hip_atomic_load(cnt, __ATOMIC_RELAXED, __HIP_MEMORY_SCOPE_AGENT) < need) __builtin_amdgcn_s_sleep(2);
    __builtin_amdgcn_fence(__ATOMIC_ACQUIRE, "agent");
    asm volatile("s_waitcnt vmcnt(0)" ::: "memory");
  }
  __syncthreads();
}
#define GLDS16(src_, dst_) __builtin_amdgcn_global_load_lds((const unsigned*)(src_), (unsigned*)(dst_), 16, 0, 0)

DEV void gla_block(const Params& p, int g) {
  const int tidx = otid();
  const int wave = __builtin_amdgcn_readfirstlane(tidx >> 6), lane = tidx & 63, l31 = lane & 31, hh = lane >> 5;
  const int bh = g >> 2, b = bh >> 2, h = bh & 3, dkh = wave >> 2, vs = (g & 3) * 4 + (wave & 3);
  const bf16_t* Qp = (const bf16_t*)(p.ws + OFF_QP);
  const bf16_t* KeT = (const bf16_t*)(p.ws + OFF_KET);
  const bf16_t* gvT = (const bf16_t*)(p.ws + OFF_GVT);
  const float* eb = (const float*)(p.ws + OFF_EB);
  f32x16 S[4];
#pragma unroll
  for (int t = 0; t < 4; ++t) for (int gg = 0; gg < 16; ++gg) S[t][gg] = 0.f;
  const bf16_t* vrow = gvT + ((size_t)(b * 2048 + h * 512 + vs * 32 + l31)) * 2048 + 8 * hh;
  const bf16_t* qsrc; const bf16_t* ksrc;
  {
    const int rq = lane >> 5, pq = lane & 31;
    const int rk = lane >> 3, pk = lane & 7;
    qsrc = Qp + ((size_t)b * 2048 + rq) * 1024 + h * 256;
    ksrc = KeT + ((size_t)((b * 4 + h) * 256 + rk)) * 2048;
    (void)pq; (void)pk;
  }
#define GLA_DMA(c_, buf_) do { const int tok0_ = (c_) * 64; \
    _Pragma("unroll") for (int i_ = 0; i_ < 8; ++i_) { const int k_ = wave * 8 + i_; \
      if (k_ < 32) { const int r_ = 2 * k_ + (lane >> 5); \
        GLDS16(qsrc + (size_t)(tok0_ + 2 * k_) * 1024 + (((lane & 31) ^ (r_ & 31)) * 8), smem + (buf_) * 65536 + k_ * 1024 + lane * 16); } \
      else { const int kk_ = k_ - 32, r_ = 8 * kk_ + (lane >> 3); \
        GLDS16(ksrc + (size_t)(8 * kk_) * 2048 + tok0_ + (((lane & 7) ^ ((r_ >> 1) & 7)) * 8), smem + (buf_) * 65536 + 32768 + kk_ * 1024 + lane * 16); } } } while (0)
#define GLA_EB(c_, buf_) do { if (wave == 0) GLDS16(eb + (size_t)(b * 32 + (c_)) * 1024 + h * 256 + lane * 4, smem + 131072 + (buf_) * 1024 + lane * 16); } while (0)
  const int Q0 = l31 * 512 + (((16 * dkh + hh) ^ l31) * 16);
  const int K0 = 32768 + (128 * dkh + l31) * 128 + ((hh ^ ((l31 >> 1) & 7)) * 16);
  asm volatile("s_waitcnt vmcnt(0)" ::: "memory");
  __syncthreads();
  GLA_DMA(0, 0); GLA_EB(0, 0);
  bf16x8 vf[4], vfn[4];
#pragma unroll
  for (int s4 = 0; s4 < 4; ++s4) { vf[s4] = ld16(vrow + 16 * s4); vfn[s4] = vf[s4]; }
  asm volatile("s_waitcnt vmcnt(0)" ::: "memory");
  __syncthreads();
#pragma unroll 1
  for (int c = 0; c < 32; ++c) {
    const int tok0 = c * 64, buf = c & 1;
    const size_t grow = (size_t)b * 2048 + tok0;
    if (c + 1 < 32) {
      GLA_DMA(c + 1, buf ^ 1); GLA_EB(c + 1, buf ^ 1);
#pragma unroll
      for (int s4 = 0; s4 < 4; ++s4) vfn[s4] = ld16(vrow + tok0 + 64 + 16 * s4);
    }
    const char* lq = smem + buf * 65536;
    int q0v = Q0, k0v = K0;
    asm volatile("" : "+v"(q0v), "+v"(k0v));
    f32x16 o0, o1;
    for (int gg = 0; gg < 16; ++gg) { o0[gg] = 0.f; o1[gg] = 0.f; }
#pragma unroll
    for (int th = 0; th < 2; ++th) {
      bf16x8 qa[2][2], qb_[2][2];
#pragma unroll
      for (int t = 0; t < 2; ++t)
#pragma unroll
        for (int s = 0; s < 2; ++s) { qa[t][s] = *(const bf16x8*)(lq + (q0v ^ (64 * (2 * th + t) + 32 * s))); qb_[t][s] = *(const bf16x8*)(lq + (q0v ^ (64 * (2 * th + t) + 32 * s)) + 32 * 512); }
      __builtin_amdgcn_sched_barrier(0);
#pragma unroll
      for (int t = 0; t < 2; ++t) {
        const bf16x8 s0 = cvt8<0>(S[2 * th + t]), s1 = cvt8<1>(S[2 * th + t]);
        o0 = mfma32(s0, qa[t][0], o0); o1 = mfma32(s0, qb_[t][0], o1);
        o0 = mfma32(s1, qa[t][1], o0); o1 = mfma32(s1, qb_[t][1], o1);
      }
      __builtin_amdgcn_sched_barrier(0);
    }
    {
      const float* ebl = (const float*)(smem + 131072 + buf * 1024) + dkh * 128 + 4 * hh;
#pragma unroll
      for (int t = 0; t < 4; ++t)
#pragma unroll
        for (int q = 0; q < 4; ++q) { const f32x4 e4 = *(const f32x4*)(ebl + 32 * t + 8 * q); for (int j = 0; j < 4; ++j) S[t][4 * q + j] *= e4[j]; }
#pragma unroll
      for (int sh = 0; sh < 2; ++sh) {
        bf16x8 kf[4][2];
#pragma unroll
        for (int t = 0; t < 4; ++t)
#pragma unroll
          for (int s = 0; s < 2; ++s) kf[t][s] = *(const bf16x8*)(lq + (k0v ^ (32 * (2 * sh + s))) + t * 4096);
        __builtin_amdgcn_sched_barrier(0);
#pragma unroll
        for (int s = 0; s < 2; ++s)
#pragma unroll
          for (int t = 0; t < 4; ++t) S[t] = mfma32(kf[t][s], vf[2 * sh + s], S[t]);
        __builtin_amdgcn_sched_barrier(0);
      }
    }
#pragma unroll
    for (int s4 = 0; s4 < 4; ++s4) vf[s4] = vfn[s4];
    u32x2* xch = (u32x2*)(smem + 135168) + (wave & 3) * 512 + lane;
    __syncthreads();
    if (dkh == 1) {
#pragma unroll
      for (int q = 0; q < 4; ++q) {
        const f32x4 a0 = {o0[4 * q], o0[4 * q + 1], o0[4 * q + 2], o0[4 * q + 3]}, a1 = {o1[4 * q], o1[4 * q + 1], o1[4 * q + 2], o1[4 * q + 3]};
        xch[q * 64] = pk4(a0); xch[(4 + q) * 64] = pk4(a1);
      }
    }
    asm volatile("s_waitcnt vmcnt(0)" ::: "memory");
    __syncthreads();
    if (dkh == 0) {
      u32x2* o_ = (u32x2*)(p.ws + OFF_OP0) + ((((size_t)((b * 32 + c) * 4 + h) * 16 + vs) * 2) * 4) * 64 + lane;
#pragma unroll
      for (int q = 0; q < 4; ++q) {
        const f32x4 a0 = {o0[4 * q], o0[4 * q + 1], o0[4 * q + 2], o0[4 * q + 3]}, a1 = {o1[4 * q], o1[4 * q + 1], o1[4 * q + 2], o1[4 * q + 3]};
        o_[q * 64] = pk4(a0 + unpk4(xch[q * 64])); o_[(4 + q) * 64] = pk4(a1 + unpk4(xch[(4 + q) * 64]));
      }
    }
  }
  asm volatile("s_waitcnt vmcnt(0)" ::: "memory");
  __syncthreads();
#undef GLA_EB
#undef GLA_DMA
  panel_publish((unsigned*)(p.ws + OFF_MISC + 2048 + 768) + bh, tidx);
}

template <bool DIAG>
DEV void sb_tile(const char* lk, const char* lv, const int ko0, const int vo0, const bf16x8 (&qf)[8], f32x16 (&O)[4], float& accp,
                 const int l31, const int hh) {
  f32x16 z;
  for (int g = 0; g < 16; ++g) z[g] = 0.f;
  {
    bf16x8 kf[8];
#pragma unroll
    for (int s = 0; s < 8; ++s) kf[s] = *(const bf16x8*)(lk + (ko0 ^ (32 * s)));
    __builtin_amdgcn_sched_barrier(0);
#pragma unroll
    for (int s = 0; s < 8; ++s) z = mfma32(kf[s], qf[s], z);
  }
  bf16x8 vf[4][2];
#pragma unroll
  for (int d = 0; d < 4; ++d) { vf[d][0] = *(const bf16x8*)(lv + d * 4096 + vo0); vf[d][1] = *(const bf16x8*)(lv + d * 4096 + (vo0 ^ 32)); }
  __builtin_amdgcn_sched_barrier(0);
  float be[16], om[16];
#pragma unroll
  for (int g = 0; g < 16; ++g) {
    const float e = __builtin_amdgcn_exp2f(fminf(-z[g], 120.f));
    be[g] = __builtin_amdgcn_rcpf(1.f + e);
    om[g] = e * be[g];
    if (DIAG) { const int kl = (g & 3) + 8 * (g >> 2) + 4 * hh; if (kl >= l31) { be[g] = 0.f; om[g] = 1.f; } }
  }
  float gp[4], pp[4], tot[4];
#pragma unroll
  for (int q = 0; q < 4; ++q) { gp[q] = (om[4 * q] * om[4 * q + 1]) * (om[4 * q + 2] * om[4 * q + 3]); pp[q] = __shfl_xor(gp[q], 32); tot[q] = gp[q] * pp[q]; }
  float suf[4];
  suf[3] = accp; suf[2] = suf[3] * tot[3]; suf[1] = suf[2] * tot[2]; suf[0] = suf[1] * tot[1];
  accp = suf[0] * tot[0];
  f32x16 w;
#pragma unroll
  for (int q = 0; q < 4; ++q) {
    float a = suf[q] * (hh == 0 ? pp[q] : 1.f);
    w[4 * q + 3] = be[4 * q + 3] * a; a *= om[4 * q + 3];
    w[4 * q + 2] = be[4 * q + 2] * a; a *= om[4 * q + 2];
    w[4 * q + 1] = be[4 * q + 1] * a; a *= om[4 * q + 1];
    w[4 * q + 0] = be[4 * q + 0] * a;
  }
  const bf16x8 w0 = cvt8<0>(w), w1 = cvt8<1>(w);
#pragma unroll
  for (int d = 0; d < 4; ++d) { O[d] = mfma32(vf[d][0], w0, O[d]); O[d] = mfma32(vf[d][1], w1, O[d]); }
}

DEV void sb_block(const Params& p, int item) {
  const int tidx = otid();
  const int wave = __builtin_amdgcn_readfirstlane(tidx >> 6), lane = tidx & 63, l31 = lane & 31, hh = lane >> 5;
  const int qb = 7 - (item >> 6), bh = item & 63, b = bh >> 4, h = bh & 15;
  const int qt = 8 * qb + wave;
  const bf16_t* sq = (const bf16_t*)(p.ws + OFF_SQ);
  const bf16_t* sk = (const bf16_t*)(p.ws + OFF_SK);
  const bf16_t* svT = (const bf16_t*)(p.ws + OFF_SVT);
  const bf16_t* ssg = (const bf16_t*)(p.ws + OFF_SSG);
  bf16_t* ob = (bf16_t*)(p.ws + OFF_OB);
  const size_t row0 = (size_t)b * 2048;
  bf16x8 qf[8];
  {
    const bf16_t* qp = sq + (row0 + qt * 32 + l31) * 2048 + h * 128 + 8 * hh;
#pragma unroll
    for (int s = 0; s < 8; ++s) qf[s] = ld16(qp + 16 * s);
  }
  f32x16 O[4];
#pragma unroll
  for (int d = 0; d < 4; ++d) for (int g = 0; g < 16; ++g) O[d][g] = 0.f;
  float accp = 1.f;
  const bf16_t* ksrc = sk + (row0 + (lane >> 4)) * 2048 + h * 128;
  const bf16_t* vsrc = svT + ((size_t)(b * 2048 + h * 128 + (lane >> 3))) * 2048;
#define SB_DMA(j_, buf_) do { \
    _Pragma("unroll") for (int i_ = 0; i_ < 4; ++i_) { const int k_ = wave * 4 + i_; \
      if (k_ < 16) { const int r_ = 4 * k_ + (lane >> 4); \
        GLDS16(ksrc + (size_t)(64 * (j_) + 4 * k_) * 2048 + (((lane & 15) ^ (r_ & 15)) * 8), smem + (buf_) * 32768 + k_ * 1024 + lane * 16); } \
      else { const int kk_ = k_ - 16, r_ = 8 * kk_ + (lane >> 3); \
        GLDS16(vsrc + (size_t)(8 * kk_) * 2048 + 64 * (j_) + (((lane & 7) ^ ((r_ >> 1) & 7)) * 8), smem + (buf_) * 32768 + 16384 + kk_ * 1024 + lane * 16); } } } while (0)
  const int KO0 = l31 * 256 + ((hh ^ (l31 & 15)) * 16);
  const int VO0 = 16384 + l31 * 128 + ((hh ^ ((l31 >> 1) & 7)) * 16);
  const int nsteps = 4 * qb + 4;
  asm volatile("s_waitcnt vmcnt(0)" ::: "memory");
  __syncthreads();
  { const int j0 = nsteps - 1; SB_DMA(j0, 0); SB_DMA((j0 > 0 ? j0 - 1 : 0), 1); SB_DMA((j0 > 1 ? j0 - 2 : 0), 2); }
#pragma unroll 1
  for (int n = 0; n < nsteps; ++n) {
    const int j = nsteps - 1 - n, buf = n & 3;
    asm volatile("s_waitcnt vmcnt(8)" ::: "memory");
    __builtin_amdgcn_s_barrier();
    asm volatile("" ::: "memory");
    { const int jn = j > 3 ? j - 3 : 0; SB_DMA(jn, (n + 3) & 3); }
    const char* lb_ = smem + buf * 32768;
    int ko0 = KO0, vo0 = VO0;
    asm volatile("" : "+v"(ko0), "+v"(vo0));
    if (2 * j + 1 == qt) sb_tile<true>(lb_ + 32 * 256, lb_, ko0, vo0 ^ 64, qf, O, accp, l31, hh);
    else if (2 * j + 1 < qt) sb_tile<false>(lb_ + 32 * 256, lb_, ko0, vo0 ^ 64, qf, O, accp, l31, hh);
    if (2 * j == qt) sb_tile<true>(lb_, lb_, ko0, vo0, qf, O, accp, l31, hh);
    else if (2 * j < qt) sb_tile<false>(lb_, lb_, ko0, vo0, qf, O, accp, l31, hh);
    asm volatile("" ::: "memory");
  }
  asm volatile("s_waitcnt vmcnt(0)" ::: "memory");
#undef SB_DMA
  __syncthreads();
  {
    char* lw = smem + wave * 16384;
#pragma unroll
    for (int d = 0; d < 4; ++d)
#pragma unroll
      for (int q = 0; q < 4; ++q) {
        const f32x4 o = {O[d][4 * q], O[d][4 * q + 1], O[d][4 * q + 2], O[d][4 * q + 3]};
        *(f32x4*)(lw + l31 * 512 + (((8 * d + 2 * q + hh) ^ l31) * 16)) = o;
      }
    asm volatile("s_waitcnt lgkmcnt(0)" ::: "memory");
    const size_t tok0 = row0 + qt * 32;
    u32x2 gv[16];
#pragma unroll
    for (int i = 0; i < 16; ++i) { const int r = 2 * i + hh, c = l31 ^ r; gv[i] = __builtin_nontemporal_load((const u32x2*)(ssg + (tok0 + r) * 2048 + h * 128 + 4 * c)); }
#pragma unroll
    for (int i = 0; i < 16; ++i) {
      const int r = 2 * i + hh, c = l31 ^ r;
      const f32x4 o = *(const f32x4*)(lw + r * 512 + l31 * 16);
      *(u32x2*)(ob + (tok0 + r) * 2048 + h * 128 + 4 * c) = pk4(o * unpk4(gv[i]));
    }
  }
  panel_publish((unsigned*)(p.ws + OFF_MISC + 2048 + 896) + (b * 8 + qb), tidx);
  __syncthreads();
}

DEV void mem_block(const Params& p, int item) {
  const int tidx = otid();
  const int wave = __builtin_amdgcn_readfirstlane(tidx >> 6), lane = tidx & 63, l31 = lane & 31, hh = lane >> 5;
  const int h = item & 3, qblk = item >> 2, qt = qblk * 8 + wave, b = qblk >> 3;
  const size_t tok = (size_t)qt * 32 + l31;
  const bf16_t* qp = (const bf16_t*)(p.ws + OFF_MQ) + tok * 2048 + h * 512 + 8 * hh;
  const bf16_t* ksrc = (const bf16_t*)(p.ws + OFF_MK) + ((size_t)(b * 256 + (lane >> 3))) * 2048 + h * 512;
  const bf16_t* vsrc = (const bf16_t*)(p.ws + OFF_MVT) + ((size_t)(b * 2048 + h * 512 + (lane >> 5))) * 256;
  bf16_t* om = (bf16_t*)(p.ws + OFF_OM);
#define MEM_DMA(n_, buf_) do { \
    _Pragma("unroll") for (int i_ = 0; i_ < 4; ++i_) { const int k_ = wave * 4 + i_; \
      if ((n_) < 8) { const int r_ = 8 * k_ + (lane >> 3); \
        GLDS16(ksrc + (size_t)(8 * k_) * 2048 + 64 * (n_) + (((lane & 7) ^ ((r_ >> 1) & 7)) * 8), smem + (buf_) * 32768 + k_ * 1024 + lane * 16); } \
      else { const int r_ = 2 * k_ + (lane >> 5); \
        GLDS16(vsrc + (size_t)(64 * ((n_) - 8) + 2 * k_) * 256 + (((lane & 31) ^ (r_ & 31)) * 8), smem + (buf_) * 32768 + k_ * 1024 + lane * 16); } } } while (0)
  const int KF0 = l31 * 128 + ((hh ^ ((l31 >> 1) & 7)) * 16);
  f32x16 Sx[8];
#pragma unroll
  for (int t = 0; t < 8; ++t) for (int g = 0; g < 16; ++g) Sx[t][g] = 0.f;
  asm volatile("s_waitcnt vmcnt(0)" ::: "memory");
  __syncthreads();
  bf16x8 bq[3][4];
#pragma unroll
  for (int kq = 0; kq < 4; ++kq) bq[0][kq] = ld16(qp + 16 * kq);
  MEM_DMA(0, 0);
#pragma unroll
  for (int kq = 0; kq < 4; ++kq) bq[1][kq] = ld16(qp + 64 + 16 * kq);
  MEM_DMA(1, 1);
#pragma unroll
  for (int n = 0; n < 8; ++n) {
    const int buf = n % 3, nb = (n + 2) % 3;
    asm volatile("s_waitcnt vmcnt(8)" ::: "memory");
    __builtin_amdgcn_s_barrier();
    asm volatile("" ::: "memory");
    {
      const int nq = n + 2 < 8 ? n + 2 : 7;
#pragma unroll
      for (int kq = 0; kq < 4; ++kq) bq[nb][kq] = ld16(qp + 64 * nq + 16 * kq);
    }
    MEM_DMA(n + 2, nb);
    const char* lf = smem + buf * 32768;
    int kf0 = KF0;
    asm volatile("" : "+v"(kf0));
#pragma unroll
    for (int kq = 0; kq < 4; ++kq) {
      bf16x8 kf[8];
#pragma unroll
      for (int t = 0; t < 8; ++t) kf[t] = *(const bf16x8*)(lf + t * 4096 + (kf0 ^ (32 * kq)));
      __builtin_amdgcn_sched_barrier(0);
#pragma unroll
      for (int t = 0; t < 8; ++t) Sx[t] = mfma32(kf[t], bq[buf][kq], Sx[t]);
    }
    asm volatile("" ::: "memory");
  }
  int buf = 8 % 3;
  float mx = -1e30f;
#pragma unroll
  for (int t = 0; t < 8; ++t) for (int g = 0; g < 16; ++g) mx = fmaxf(mx, Sx[t][g]);
  mx = fmaxf(mx, __shfl_xor(mx, 32));
  float sum = 0.f;
#pragma unroll
  for (int t = 0; t < 8; ++t) for (int g = 0; g < 16; ++g) { const float e = __expf(Sx[t][g] - mx); Sx[t][g] = e; sum += e; }
  sum += __shfl_xor(sum, 32);
  const float inv = 1.f / sum;
  bf16x8 pf[8][2];
#pragma unroll
  for (int t = 0; t < 8; ++t) { pf[t][0] = cvt8<0>(Sx[t]); pf[t][1] = cvt8<1>(Sx[t]); }
  const int VF0 = l31 * 512 + ((hh ^ l31) * 16);
#pragma unroll 1
  for (int n = 8; n < 16; ++n) {
    if (n == 8) asm volatile("s_waitcnt vmcnt(4)" ::: "memory");
    else if (n == 9) asm volatile("s_waitcnt vmcnt(8)" ::: "memory");
    else asm volatile("s_waitcnt vmcnt(12)" ::: "memory");
    __builtin_amdgcn_s_barrier();
    asm volatile("" ::: "memory");
    const int nb = buf >= 1 ? buf - 1 : 2;
    { const int nn = n + 2 < 16 ? n + 2 : 15; MEM_DMA(nn, nb); }
    const char* lf = smem + buf * 32768;
    int vf0 = VF0;
    asm volatile("" : "+v"(vf0));
    char* lw = smem + 98304 + wave * 4096;
#pragma unroll
    for (int dd = 0; dd < 2; ++dd) {
      f32x16 o;
      for (int g = 0; g < 16; ++g) o[g] = 0.f;
#pragma unroll
      for (int t = 0; t < 8; ++t) { o = mfma32(*(const bf16x8*)(lf + dd * 16384 + (vf0 ^ (64 * t))), pf[t][0], o); o = mfma32(*(const bf16x8*)(lf + dd * 16384 + (vf0 ^ (64 * t + 32))), pf[t][1], o); }
#pragma unroll
      for (int q = 0; q < 4; ++q) {
        f32x4 v = {o[4 * q] * inv, o[4 * q + 1] * inv, o[4 * q + 2] * inv, o[4 * q + 3] * inv};
        *(u32x2*)(lw + l31 * 128 + (((4 * dd + q) ^ (l31 & 7)) * 16) + hh * 8) = pk4(v);
      }
    }
    asm volatile("s_waitcnt lgkmcnt(0)" ::: "memory");
#pragma unroll
    for (int i = 0; i < 4; ++i) {
      const int id = i * 64 + lane, r = id >> 3, pos = id & 7, c = pos ^ (r & 7);
      *(u32x4*)(om + ((size_t)qt * 32 + r) * 2048 + h * 512 + 64 * (n - 8) + 8 * c) = *(const u32x4*)(lw + r * 128 + pos * 16);
    }
    buf = buf == 2 ? 0 : buf + 1;
    asm volatile("" ::: "memory");
  }
#undef MEM_DMA
  panel_publish((unsigned*)(p.ws + OFF_MISC + 2048 + 896) + qblk, tidx);
  __syncthreads();
}

DEV void phase2(const Params& p, int rerun) {
  const int tidx = otid();
  const int parts = rerun ? PROBE_PART : 7;
  if (parts & 1) for (int g = blockIdx.x; g < 64; g += gridDim.x) gla_block(p, g);
  unsigned* ctr = (unsigned*)(p.ws + OFF_MISC + (rerun ? 256 : 0));
  volatile int* slot = (volatile int*)(smem + 131072 + 2048);
  unsigned* mkv_done = (unsigned*)(p.ws + OFF_MISC + 1024);
  const int nstatic = ((parts & 1) && gridDim.x > 64) ? (int)gridDim.x - 64 : ((parts & 1) ? 0 : (int)gridDim.x);
  bool first = ((parts & 1) ? (int)blockIdx.x >= 64 && nstatic > 0 : true);
  const int firstit = (parts & 1) ? (int)blockIdx.x - 64 : (int)blockIdx.x;
  while (true) {
    __syncthreads();
    if (tidx == 0) *slot = first ? firstit : (int)(nstatic + atomicAdd(ctr, 1u));
    first = false;
    __syncthreads();
    const int it = __builtin_amdgcn_readfirstlane(*slot);
    if (it >= 64 + 512 + 128) break;
    if (it < 64) {
      phase1(p, 2816 + it);
      __threadfence();
      __syncthreads();
      if (tidx == 0) atomicAdd(mkv_done, 1u);
    } else if (it < 64 + 320) { if (parts & 2) sb_block(p, it - 64); }
    else if (it >= 64 + 320 + 128) { if (parts & 2) sb_block(p, it - 64 - 128); }
    else {
      if (tidx == 0) {
        while (__hip_atomic_load(mkv_done, __ATOMIC_RELAXED, __HIP_MEMORY_SCOPE_AGENT) < 64u) __builtin_amdgcn_s_sleep(8);
        __builtin_amdgcn_fence(__ATOMIC_ACQUIRE, "agent");
      }
      __syncthreads();
      if (parts & 4) mem_block(p, it - 64 - 320);
    }
  }
}

DEV void phase25(const Params& p, const bool fuse) {
  const int tidx = otid();
  const int wave = __builtin_amdgcn_readfirstlane(tidx >> 6), lane = tidx & 63, l31 = lane & 31, hh = lane >> 5;
  const bf16_t* Qp = (const bf16_t*)(p.ws + OFF_QP);
  const bf16_t* Kd = (const bf16_t*)(p.ws + OFF_KDP);
  const bf16_t* gvT = (const bf16_t*)(p.ws + OFF_GVT);
  const bf16_t* sgg = (const bf16_t*)(p.ws + OFF_SGG);
  const float* op0 = (const float*)(p.ws + OFF_OP0);
  const float* op1 = (const float*)(p.ws + OFF_OP1);
  bf16_t* oa = (bf16_t*)(p.ws + OFF_OA);
  float* ssL = (float*)(smem + 131072 + 3072);
  unsigned* ctr25 = (unsigned*)(p.ws + OFF_MISC + 1280);
  volatile int* slot25 = (volatile int*)(smem + 131072 + 2048);
  int itn = blockIdx.x;
#pragma unroll 1
  for (;;) {
    int it;
    if (fuse) {
      __syncthreads();
      if (tidx == 0) *slot25 = (int)atomicAdd(ctr25, 1u);
      __syncthreads();
      it = __builtin_amdgcn_readfirstlane(*slot25);
    } else { it = itn; itn += gridDim.x; }
    if (it >= 512) break;
    const int bh = it >> 5, c = it & 31, b = bh >> 2, h = bh & 3, tok0 = c * 64;
    const size_t grow = (size_t)b * 2048 + tok0;
    if (fuse) panel_wait((unsigned*)(p.ws + OFF_MISC + 2048 + 768) + bh, 4u, tidx);
    if (tidx < 64) ssL[tidx] = 0.f;
    if (wave < 3) {
      const int jt = (wave == 2) ? 1 : 0, i2 = (wave == 0) ? 0 : 1;
      const bf16_t* kd = Kd + (grow + 32 * jt + l31) * 1024 + h * 256 + 8 * hh;
      const bf16_t* q = Qp + (grow + 32 * i2 + l31) * 1024 + h * 256 + 8 * hh;
      f32x16 X;
      for (int g = 0; g < 16; ++g) X[g] = 0.f;
#pragma unroll
      for (int s = 0; s < 16; ++s) X = mfma32(ld16(kd + 16 * s), ld16(q + 16 * s), X);
      if (jt == i2) {
#pragma unroll
        for (int g = 0; g < 16; ++g) { const int jl = (g & 3) + 8 * (g >> 2) + 4 * hh; if (jl > l31) X[g] = 0.f; }
      }
      *(bf16x8*)(smem + (wave * 2 + 0) * 1024 + lane * 16) = cvt8<0>(X);
      *(bf16x8*)(smem + (wave * 2 + 1) * 1024 + lane * 16) = cvt8<1>(X);
    }
    f32x16 o[2][2];
#pragma unroll
    for (int dt = 0; dt < 2; ++dt)
#pragma unroll
      for (int i2 = 0; i2 < 2; ++i2)
#pragma unroll
        for (int q = 0; q < 4; ++q) {
          const size_t idx = ((((size_t)((b * 32 + c) * 4 + h) * 16 + (2 * wave + dt)) * 2 + i2) * 4 + q) * 64 + lane;
          const f32x4 a = unpk4(__builtin_nontemporal_load((const u32x2*)op0 + idx));
          for (int j = 0; j < 4; ++j) o[dt][i2][4 * q + j] = a[j];
        }
    bf16x8 vfr[2][4];
#pragma unroll
    for (int dt = 0; dt < 2; ++dt)
#pragma unroll
      for (int s4 = 0; s4 < 4; ++s4) vfr[dt][s4] = ld16(gvT + ((size_t)(b * 2048 + h * 512 + 64 * wave + 32 * dt + l31)) * 2048 + tok0 + 16 * s4 + 8 * hh);
    __syncthreads();
    {
      const char* lx = smem + lane * 16;
      const bf16x8 x00a = *(const bf16x8*)(lx), x00b = *(const bf16x8*)(lx + 1024), x01a = *(const bf16x8*)(lx + 2048), x01b = *(const bf16x8*)(lx + 3072),
                   x11a = *(const bf16x8*)(lx + 4096), x11b = *(const bf16x8*)(lx + 5120);
#pragma unroll
      for (int dt = 0; dt < 2; ++dt) {
        o[dt][0] = mfma32(vfr[dt][0], x00a, o[dt][0]); o[dt][0] = mfma32(vfr[dt][1], x00b, o[dt][0]);
        o[dt][1] = mfma32(vfr[dt][0], x01a, o[dt][1]); o[dt][1] = mfma32(vfr[dt][1], x01b, o[dt][1]);
        o[dt][1] = mfma32(vfr[dt][2], x11a, o[dt][1]); o[dt][1] = mfma32(vfr[dt][3], x11b, o[dt][1]);
      }
    }
#pragma unroll
    for (int i2 = 0; i2 < 2; ++i2) {
      float ss = 0.f;
#pragma unroll
      for (int dt = 0; dt < 2; ++dt) for (int g = 0; g < 16; ++g) ss += o[dt][i2][g] * o[dt][i2][g];
      ss += __shfl_xor(ss, 32);
      if (hh == 0) atomicAdd(&ssL[32 * i2 + l31], ss);
    }
    __syncthreads();
    {
      char* lw = smem + wave * 16384;
#pragma unroll
      for (int dt = 0; dt < 2; ++dt)
#pragma unroll
        for (int i2 = 0; i2 < 2; ++i2)
#pragma unroll
          for (int q = 0; q < 4; ++q) {
            const f32x4 v = {o[dt][i2][4 * q], o[dt][i2][4 * q + 1], o[dt][i2][4 * q + 2], o[dt][i2][4 * q + 3]};
            const int r = 32 * i2 + l31;
            *(f32x4*)(lw + r * 256 + (((8 * dt + 2 * q + hh) ^ (r & 15)) * 16)) = v;
          }
      asm volatile("s_waitcnt lgkmcnt(0)" ::: "memory");
      u32x2 sgv[16]; f32x4 ghv[16];
#pragma unroll
      for (int i = 0; i < 16; ++i) {
        const int id = i * 64 + lane, r = id >> 4, pos = id & 15, c = pos ^ (r & 15);
        const int dv = 64 * wave + 4 * c;
        sgv[i] = __builtin_nontemporal_load((const u32x2*)(sgg + (grow + r) * 2048 + h * 512 + dv));
        ghv[i] = *(const f32x4*)(p.g_head + dv);
      }
#pragma unroll
      for (int i = 0; i < 16; ++i) {
        const int id = i * 64 + lane, r = id >> 4, pos = id & 15, c = pos ^ (r & 15);
        const f32x4 v = *(const f32x4*)(lw + r * 256 + pos * 16);
        const float rstd = rsqrtf(ssL[r] * (1.f / 512.f) + 1e-6f);
        const int dv = 64 * wave + 4 * c;
        *(u32x2*)(oa + (grow + r) * 2048 + h * 512 + dv) = pk4(v * rstd * ghv[i] * unpk4(sgv[i]));
      }
    }
    __syncthreads();
    if (fuse) panel_publish((unsigned*)(p.ws + OFF_MISC + 2048 + 512) + (b * 8 + (c >> 2)), tidx);
  }
}

DEV void phase3(const Params& p, const bool fuse) {
  EpiMerge e; e.gates = (const bf16_t*)(p.ws + OFF_GATES); e.mg = (float*)(p.ws + OFF_MERGED); e.mbf = (bf16_t*)(p.ws + OFF_MBF);
  unsigned* cnt3 = (unsigned*)(p.ws + OFF_MISC + 2048 + 256);
  for (int L = blockIdx.x; L < 256; L += gridDim.x) {
    const int xcd = L & 7, off = L >> 3, wgid = xcd * 32 + off;
    const int pm = wgid >> 3, pn = wgid & 7;
    const int brow = pm * 256, bcol = pn * 256;
#pragma unroll 1
    for (int step = 0; step < 3; ++step) {
      const bf16_t* a = (const bf16_t*)(p.ws + (step == 0 ? OFF_OB : step == 1 ? OFF_OM : OFF_OA));
      const bf16_t* w = (const bf16_t*)(p.ws + (step == 0 ? OFF_WT_PS : step == 1 ? OFF_WT_PM : OFF_WT_PG));
      if (fuse && step == 0) panel_wait((unsigned*)(p.ws + OFF_MISC + 2048 + 896) + pm, 20u, otid());
      if (fuse && step == 2) panel_wait((unsigned*)(p.ws + OFF_MISC + 2048 + 512) + pm, 16u, otid());
      e.step = step; e.gidx = (step == 0 ? 1 : step == 1 ? 2 : 0);
      gemm_tile<true>(a, w, 2048, brow, bcol, e);
    }
    if (fuse) panel_publish(cnt3 + pm, otid());
  }
}
DEV void p5_rowpair(const Params& p, const int row0, const int lane) {
  const bf16_t* y = (const bf16_t*)(p.ws + OFF_Y);
  const float* part = (const float*)(p.ws + OFF_PART);
  float ss0 = (lane < 32) ? part[(size_t)lane * NTOK + row0] : 0.f;
  float ss1 = (lane < 32) ? part[(size_t)lane * NTOK + row0 + 1] : 0.f;
  u32x2 yv[2][8]; f32x4 xv[2][8];
#pragma unroll
  for (int r = 0; r < 2; ++r)
#pragma unroll
    for (int i = 0; i < 8; ++i) {
      const size_t idx = (size_t)(row0 + r) * DM + 4 * (lane + 64 * i);
      yv[r][i] = __builtin_nontemporal_load((const u32x2*)(y + idx)); xv[r][i] = __builtin_nontemporal_load((const f32x4*)(p.x + idx));
    }
  ss0 = wave_sum(ss0); ss1 = wave_sum(ss1);
  const float rs[2] = {rsqrtf(ss0 * (1.f / DM) + 1e-6f), rsqrtf(ss1 * (1.f / DM) + 1e-6f)};
#pragma unroll
  for (int i = 0; i < 8; ++i) {
    const f32x4 g = *(const f32x4*)(p.g_post + 4 * (lane + 64 * i));
#pragma unroll
    for (int r = 0; r < 2; ++r) {
      const size_t idx = (size_t)(row0 + r) * DM + 4 * (lane + 64 * i);
      __builtin_nontemporal_store(xv[r][i] + unpk4(yv[r][i]) * rs[r] * g, (f32x4*)(p.out + idx));
    }
  }
}
DEV void phase4(const Params& p, const bool fuse) {
  EpiOut e; e.y = (bf16_t*)(p.ws + OFF_Y); e.part = (float*)(p.ws + OFF_PART);
  unsigned* cnt = (unsigned*)(p.ws + OFF_MISC + 2048);
  unsigned* cnt3 = (unsigned*)(p.ws + OFF_MISC + 2048 + 256);
  for (int L = blockIdx.x; L < 256; L += gridDim.x) {
    const int xcd = L & 7, off = L >> 3, wgid = xcd * 32 + off;
    const int pm = wgid >> 3, pn = wgid & 7;
    const int tidx = otid();
    if (fuse) panel_wait(cnt3 + pm, 8u, tidx);
    gemm_tile<true>((const bf16_t*)(p.ws + OFF_MBF), (const bf16_t*)(p.ws + OFF_WT_OUT), 2048, pm * 256, pn * 256, e);
    if (fuse) {
      panel_publish(cnt + pm, tidx);
      panel_wait(cnt + pm, 8u, tidx);
      const int wave = tidx >> 6, lane = tidx & 63;
      const int rbase = pm * 256 + pn * 32 + wave * 4;
      p5_rowpair(p, rbase, lane);
      p5_rowpair(p, rbase + 2, lane);
    }
  }
}
DEV void phase5(const Params& p) {
  const int tidx = otid();
  const int lane = tidx & 63;
  const int gw = blockIdx.x * 8 + (tidx >> 6), nw = gridDim.x * 8;
  for (int row0 = gw * 2; row0 < NTOK; row0 += nw * 2) p5_rowpair(p, row0, lane);
}

__global__ void __launch_bounds__(512) hybrid_layer_megakernel(Params p, int ph_lo, int ph_hi) {
  if (ph_hi == 6 && gridDim.x >= 256) ph_hi = 2;
  for (int ph = ph_lo; ph <= ph_hi; ++ph) {
    for (int rep = 0; rep < ((ph == PROBE_DUP) ? 2 : 1); ++rep) {
      if (rep) cg::this_grid().sync();
      switch (ph) {
        case 0: phase0(p); break;
        case 1: phase1(p, -1); break;
        case 2: phase2(p, rep); if (gridDim.x >= 256) { phase25(p, true); phase3(p, true); phase4(p, true); } break;
        case 3: if (gridDim.x < 256) phase25(p, false); break;
        case 4: if (gridDim.x < 256) phase3(p, false); break;
        case 5: if (gridDim.x < 256) phase4(p, false); break;
        default: if (gridDim.x < 256) phase5(p); break;
      }
    }
    if (ph < ph_hi) { cg::this_grid().sync(); }
  }
}

extern "C" void kernel_launch(void* const* d_in, const int* in_sizes, int n_in, void* d_out, int out_size, void* d_ws, size_t ws_size,
                              hipStream_t stream) {
  constexpr size_t kDynLds = 131072 + 4096 + 16384;
  static int grid_blocks = 0;
  if (!grid_blocks) {
    hipFuncSetAttribute((const void*)hybrid_layer_megakernel, hipFuncAttributeMaxDynamicSharedMemorySize, (int)kDynLds);
    int dev = 0, cus = 0, per_cu = 0;
    hipGetDevice(&dev);
    hipDeviceGetAttribute(&cus, hipDeviceAttributeMultiprocessorCount, dev);
    hipOccupancyMaxActiveBlocksPerMultiprocessor(&per_cu, hybrid_layer_megakernel, 512, kDynLds);
    if (per_cu < 1) per_cu = 1;
    if (per_cu > 1) per_cu = 1;
    grid_blocks = cus * per_cu;
  }
  Params p{};
  p.x = (const float*)d_in[0]; p.mem = (const float*)d_in[1]; p.g_pre = (const float*)d_in[2]; p.g_post = (const float*)d_in[3];
  p.g_mem = (const float*)d_in[4]; p.w_in = (const float*)d_in[5]; p.a_w2 = (const float*)d_in[6]; p.a_b = (const float*)d_in[7];
  p.g_head = (const float*)d_in[8]; p.w_mkv = (const float*)d_in[9]; p.w_pg = (const float*)d_in[10]; p.w_ps = (const float*)d_in[11];
  p.w_pm = (const float*)d_in[12]; p.w_out = (const float*)d_in[13];
  p.out = (float*)d_out; p.ws = (char*)d_ws;
  hipMemsetAsync((char*)d_ws + OFF_MISC, 0, 4096, stream);
#if MK_MULTI
  for (int ph = 0; ph <= 6; ++ph) hipLaunchKernelGGL(hybrid_layer_megakernel, dim3(grid_blocks), dim3(512), kDynLds, stream, p, ph, ph);
#else
  int lo = 0, hi = 6;
  void* args[] = {&p, &lo, &hi};
  hipError_t e = hipLaunchCooperativeKernel((const void*)hybrid_layer_megakernel, dim3(grid_blocks), dim3(512), args, kDynLds, stream);
  if (e != hipSuccess) fprintf(stderr, "cooperative launch failed: %s (grid %d)\n", hipGetErrorString(e), grid_blocks);
#endif
}
```
